# Optimizing an MI355X kernel written in HIP

```python
import jax, jax.numpy as jnp
from jax import lax
import numpy as np

D_MODEL = 2048
BATCH = 2
SEQ = 8192
DEPTH = 1

CHUNK = 64
D_MIX = D_MODEL
D_MLSTM = D_MIX // 2
MLSTM_HEADS = 4
MLSTM_HEAD_DIM = D_MLSTM // MLSTM_HEADS
D_RGLRU = D_MIX - D_MLSTM
RG_BLOCKS = 8
RG_BLOCK_DIM = D_RGLRU // RG_BLOCKS
CONV_WIDTH = 4
RG_C = 8.0
D_FF = 5632
FFN_WEIGHT = 0.5
ALPHA = float((2 * DEPTH) ** 0.25)
BETA = float((8 * DEPTH) ** -0.25)
LN_EPS = 1e-5
N_SUBLAYERS = 3
IN_COLS = 4 * D_MLSTM + 2 * MLSTM_HEADS + 2 * D_RGLRU

kernel_name = "hybrid_mlstm_rglru_macaron_block"


def _layer_norm(x, gain=None, bias=None):
    xf = x.astype(jnp.float32)
    mu = xf.mean(-1, keepdims=True)
    var = jnp.square(xf - mu).mean(-1, keepdims=True)
    y = (xf - mu) * lax.rsqrt(var + LN_EPS)
    if gain is not None:
        y = y * gain.astype(jnp.float32) + bias.astype(jnp.float32)
    return y.astype(x.dtype)


def _swiglu(u, w13, w2):
    g, v = jnp.split(u @ w13, 2, axis=-1)
    return (jax.nn.silu(g) * v) @ w2


def _mlstm(q, k, v, i_pre, f_pre):
    B, S, H, Dh = q.shape
    nc = S // CHUNK

    def to_chunks(t):
        t = t.astype(jnp.float32).reshape((B, nc, CHUNK, H) + t.shape[3:])
        return jnp.moveaxis(jnp.moveaxis(t, 1, 0), 3, 2)

    qc = to_chunks(q)
    kc = to_chunks(k) * (Dh ** -0.5)
    vc = to_chunks(v)
    li = to_chunks(i_pre)
    lf = to_chunks(jax.nn.log_sigmoid(f_pre.astype(jnp.float32)))
    tri = jnp.tril(jnp.ones((CHUNK, CHUNK), dtype=bool))

    def step(carry, xs):
        C, n, m = carry
        qb, kb, vb, lib, lfb = xs
        b = jnp.cumsum(lfb, axis=-1)
        d = b[..., :, None] - b[..., None, :] + lib[..., None, :]
        d = jnp.where(tri, d, -jnp.inf)
        inter = b + m[..., None]
        m_t = jnp.maximum(inter, d.max(-1))
        w_intra = jnp.exp(d - m_t[..., None])
        w_inter = jnp.exp(inter - m_t)
        s = jnp.einsum('bhtd,bhsd->bhts', qb, kb) * w_intra
        num = (w_inter[..., None] * jnp.einsum('bhtd,bhde->bhte', qb, C)
               + jnp.einsum('bhts,bhse->bhte', s, vb))
        den = w_inter * jnp.einsum('bhtd,bhd->bht', qb, n) + s.sum(-1)
        h = num / jnp.maximum(jnp.abs(den), jnp.exp(-m_t))[..., None]
        b_last = b[..., -1]
        w_log = b_last[..., None] - b + lib
        m_new = jnp.maximum(b_last + m, w_log.max(-1))
        decay = jnp.exp(b_last + m - m_new)
        w_s = jnp.exp(w_log - m_new[..., None])
        C = decay[..., None, None] * C + jnp.einsum('bhs,bhsd,bhse->bhde', w_s, kb, vb)
        n = decay[..., None] * n + jnp.einsum('bhs,bhsd->bhd', w_s, kb)
        return (C, n, m_new), h

    init = (jnp.zeros((B, H, Dh, Dh), jnp.float32),
            jnp.zeros((B, H, Dh), jnp.float32),
            jnp.zeros((B, H), jnp.float32))
    _, hs = lax.scan(step, init, (qc, kc, vc, li, lf))
    hs = jnp.transpose(hs, (1, 0, 3, 2, 4)).reshape(B, S, H, Dh)
    return hs.astype(v.dtype)


def _causal_depthwise_conv(x, w, b):
    S = x.shape[1]
    xp = jnp.pad(x, ((0, 0), (CONV_WIDTH - 1, 0), (0, 0)))
    y = b
    for tap in range(CONV_WIDTH):
        y = y + xp[:, tap:tap + S] * w[tap]
    return y


def _rg_lru(x, wa, ba, wx, bx, lam):
    B, S, C = x.shape
    xb = x.reshape(B, S, RG_BLOCKS, RG_BLOCK_DIM)
    r = jax.nn.sigmoid(jnp.einsum('bsnd,nde->bsne', xb, wa).reshape(B, S, C) + ba)
    i = jax.nn.sigmoid(jnp.einsum('bsnd,nde->bsne', xb, wx).reshape(B, S, C) + bx)
    log_a = -RG_C * r.astype(jnp.float32) * jax.nn.softplus(-lam.astype(jnp.float32))
    a = jnp.exp(log_a)
    u = jnp.sqrt(-jnp.expm1(2.0 * log_a)) * (i * x).astype(jnp.float32)

    def combine(left, right):
        a1, b1 = left
        a2, b2 = right
        return a1 * a2, a2 * b1 + b2

    _, h = lax.associative_scan(combine, (a, u), axis=1)
    return h.astype(x.dtype)


def setup_inputs(seed: int = 0) -> dict:
    key = jax.random.key(seed)
    ks = jax.random.split(key, 24)
    nrm = jax.random.normal
    f32 = jnp.float32
    x = nrm(ks[0], (BATCH, SEQ, D_MODEL), f32)
    c = nrm(ks[1], (BATCH, D_MODEL), f32)
    w_ada = nrm(ks[2], (DEPTH, D_MODEL, N_SUBLAYERS * 3 * D_MODEL), f32) * D_MODEL ** -0.5
    b_ada = 0.01 * nrm(ks[3], (DEPTH, N_SUBLAYERS * 3 * D_MODEL), f32)
    ffn1_w13 = nrm(ks[4], (DEPTH, D_MODEL, 2 * D_FF), f32) * D_MODEL ** -0.5
    ffn1_w2 = nrm(ks[5], (DEPTH, D_FF, D_MODEL), f32) * (D_FF ** -0.5 * BETA)
    w_in = nrm(ks[6], (DEPTH, D_MODEL, IN_COLS), f32) * D_MODEL ** -0.5
    f_start = 4 * D_MLSTM + MLSTM_HEADS
    b_in = 0.01 * nrm(ks[7], (DEPTH, IN_COLS), f32)
    b_in = b_in.at[:, f_start:f_start + MLSTM_HEADS].add(
        jnp.linspace(3.0, 6.0, MLSTM_HEADS, dtype=f32))
    mlstm_norm_g = 1.0 + 0.02 * nrm(ks[8], (DEPTH, MLSTM_HEADS, MLSTM_HEAD_DIM), f32)
    rg_conv_w = nrm(ks[9], (DEPTH, CONV_WIDTH, D_RGLRU), f32) * CONV_WIDTH ** -0.5
    rg_conv_b = 0.01 * nrm(ks[10], (DEPTH, D_RGLRU), f32)
    rg_wa = nrm(ks[11], (DEPTH, RG_BLOCKS, RG_BLOCK_DIM, RG_BLOCK_DIM), f32) * RG_BLOCK_DIM ** -0.5
    rg_ba = 0.01 * nrm(ks[12], (DEPTH, D_RGLRU), f32)
    rg_wx = nrm(ks[13], (DEPTH, RG_BLOCKS, RG_BLOCK_DIM, RG_BLOCK_DIM), f32) * RG_BLOCK_DIM ** -0.5
    rg_bx = 0.01 * nrm(ks[14], (DEPTH, D_RGLRU), f32)
    a_pow = jax.random.uniform(ks[15], (DEPTH, D_RGLRU), f32, 0.9, 0.999)
    p = a_pow ** (1.0 / RG_C)
    rg_lambda = jnp.log(p) - jnp.log1p(-p)
    w_out = nrm(ks[16], (DEPTH, D_MIX, D_MODEL), f32) * (D_MIX ** -0.5 * BETA)
    ffn2_w13 = nrm(ks[17], (DEPTH, D_MODEL, 2 * D_FF), f32) * D_MODEL ** -0.5
    ffn2_w2 = nrm(ks[18], (DEPTH, D_FF, D_MODEL), f32) * (D_FF ** -0.5 * BETA)
    ln_g = 1.0 + 0.02 * nrm(ks[19], (DEPTH, N_SUBLAYERS, D_MODEL), f32)
    ln_b = 0.01 * nrm(ks[20], (DEPTH, N_SUBLAYERS, D_MODEL), f32)
    return {"x": x, "c": c, "w_ada": w_ada, "b_ada": b_ada,
            "ffn1_w13": ffn1_w13, "ffn1_w2": ffn1_w2,
            "w_in": w_in, "b_in": b_in, "mlstm_norm_g": mlstm_norm_g,
            "rg_conv_w": rg_conv_w, "rg_conv_b": rg_conv_b,
            "rg_wa": rg_wa, "rg_ba": rg_ba, "rg_wx": rg_wx, "rg_bx": rg_bx,
            "rg_lambda": rg_lambda, "w_out": w_out,
            "ffn2_w13": ffn2_w13, "ffn2_w2": ffn2_w2,
            "ln_g": ln_g, "ln_b": ln_b}


def reference(x, c, w_ada, b_ada, ffn1_w13, ffn1_w2, w_in, b_in, mlstm_norm_g,
              rg_conv_w, rg_conv_b, rg_wa, rg_ba, rg_wx, rg_bx, rg_lambda, w_out,
              ffn2_w13, ffn2_w2, ln_g, ln_b):
    B, S, _ = x.shape
    H, Dh = MLSTM_HEADS, MLSTM_HEAD_DIM
    for l in range(DEPTH):
        mod = (jax.nn.silu(c) @ w_ada[l] + b_ada[l]).reshape(B, N_SUBLAYERS, 3, D_MODEL)
        shift, scale, gate = mod[:, :, 0], mod[:, :, 1], mod[:, :, 2]

        def modulate(h, s):
            return _layer_norm(h) * (1.0 + scale[:, s, None, :]) + shift[:, s, None, :]

        y = _swiglu(modulate(x, 0), ffn1_w13[l], ffn1_w2[l])
        x = _layer_norm(ALPHA * x + FFN_WEIGHT * gate[:, 0, None, :] * y, ln_g[l, 0], ln_b[l, 0])

        u = modulate(x, 1)
        proj = u @ w_in[l] + b_in[l]
        q, k, v, o, i_pre, f_pre, x_rg, g_rg = jnp.split(
            proj, [D_MLSTM, 2 * D_MLSTM, 3 * D_MLSTM, 4 * D_MLSTM,
                   4 * D_MLSTM + H, 4 * D_MLSTM + 2 * H,
                   4 * D_MLSTM + 2 * H + D_RGLRU], axis=-1)
        h_m = _mlstm(q.reshape(B, S, H, Dh), k.reshape(B, S, H, Dh),
                     v.reshape(B, S, H, Dh), i_pre, f_pre)
        h_m = (_layer_norm(h_m) * mlstm_norm_g[l]).reshape(B, S, D_MLSTM) * jax.nn.sigmoid(o)
        x_rg = _causal_depthwise_conv(x_rg, rg_conv_w[l], rg_conv_b[l])
        h_r = _rg_lru(x_rg, rg_wa[l], rg_ba[l], rg_wx[l], rg_bx[l], rg_lambda[l])
        h_r = h_r * jax.nn.gelu(g_rg)
        y = jnp.concatenate([h_m, h_r], axis=-1) @ w_out[l]
        x = _layer_norm(ALPHA * x + gate[:, 1, None, :] * y, ln_g[l, 1], ln_b[l, 1])

        y = _swiglu(modulate(x, 2), ffn2_w13[l], ffn2_w2[l])
        x = _layer_norm(ALPHA * x + FFN_WEIGHT * gate[:, 2, None, :] * y, ln_g[l, 2], ln_b[l, 2])
    return x
```

```cpp
#include <hip/hip_runtime.h>
#include <hip/hip_cooperative_groups.h>
#include <cstdio>
#include <cstdint>
namespace cg = cooperative_groups;
__device__ __forceinline__ int otid() { int t = threadIdx.x; asm volatile("" : "+v"(t)); return t; }
namespace pg8 {
#define PG8_LAS __attribute__((address_space(3)))
typedef unsigned short bf16_t;
typedef short bf16x8 __attribute__((ext_vector_type(8)));
typedef float f32x4 __attribute__((ext_vector_type(4)));
typedef unsigned u32x4 __attribute__((ext_vector_type(4)));
constexpr int BM = 256, BK = 64, HALF = 128, HTB = HALF * BK * 2  , STAGE_BYTES = 8 * HTB, NXCD = 8, WGM = 8;

__host__ __device__ __forceinline__ int lds_byte(int r, int c) { const int st = (r >> 4) * 2 + (c >> 5), rr = r & 15, cc = c & 31, ob = rr * 64 + cc * 2; return st * 1024 + (ob ^ (((ob >> 9) & 1) << 5)); }
__host__ __device__ __forceinline__ void stage_rc(int b, int& R, int& C) { const int st = b / 1024, sb = b % 1024, swz = sb ^ (((sb >> 9) & 1) << 5); R = (st >> 1) * 16 + swz / 64; C = (st & 1) * 32 + (swz % 64) / 2; }
__host__ __device__ __forceinline__ int perm32(int rho) { const int n = rho >> 4, i = rho & 15; return 8 * (i >> 2) + 4 * n + (i & 3); }

struct Unit { int pm, pn; };
struct Gemm { const bf16_t* A; const bf16_t* Bt; int M, N, K; };

struct StaticOrder {
    int nM, nN, nwg, G, c;
    __host__ __device__ void init(int M, int N, int G_, int c_) { nM = M / BM; nN = N / BM; nwg = nM * nN; G = G_; c = c_; }
    __host__ __device__ bool next(int i, Unit& u) const {
        const long L = (long)i * G + c; if (L >= nwg) return false;
        int wgid = (int)L; { const int q = nwg / NXCD, r = nwg % NXCD, xcd = wgid % NXCD, off = wgid / NXCD; wgid = (xcd < r ? xcd * (q + 1) : r * (q + 1) + (xcd - r) * q) + off; }
        const int nig = WGM * nN, gid = wgid / nig, fm = gid * WGM, gsz = (nM - fm) < WGM ? (nM - fm) : WGM;
        u.pm = fm + ((wgid % nig) % gsz); u.pn = (wgid % nig) / gsz; return true;
    }
    __device__ __forceinline__ void a_ready(const Unit&) const {}
    __device__ __forceinline__ void done(const Unit&) const {}
};
__device__ __forceinline__ unsigned cvt_pk_bf16(float lo, float hi) { unsigned r; asm volatile("v_cvt_pk_bf16_f32 %0, %1, %2" : "=v"(r) : "v"(lo), "v"(hi)); return r; }
struct EpiSwiglu {
    static constexpr bool PERM = true, AFTER_DRAIN = false;
    bf16_t* O; int ldc;
    __device__ __forceinline__ void operator()(const f32x4 (&acc)[2][2][4][2], const Unit& u, int wr, int wc, int fr, int fq) const {
        const int row0 = u.pm * BM + wr * 64 + fr, col0 = u.pn * HALF + wc * 32 + 8 * fq;
#pragma unroll
        for (int ai = 0; ai < 2; ++ai)
#pragma unroll
            for (int m = 0; m < 4; ++m) { bf16_t* rowp = O + (size_t)(row0 + ai * HALF + m * 16) * ldc + col0;
                float h[8];
#pragma unroll
                for (int n = 0; n < 2; ++n)
#pragma unroll
                    for (int j = 0; j < 4; ++j) { const float g = acc[ai][0][m][n][j], v = acc[ai][1][m][n][j]; h[4 * n + j] = g * __builtin_amdgcn_rcpf(1.0f + __expf(-g)) * v; }
                u32x4 w; w.x = cvt_pk_bf16(h[0], h[1]); w.y = cvt_pk_bf16(h[2], h[3]); w.z = cvt_pk_bf16(h[4], h[5]); w.w = cvt_pk_bf16(h[6], h[7]);
                *(u32x4*)rowp = w; }
    }
};
struct EpiRes {
    static constexpr bool PERM = false, AFTER_DRAIN = false;
    const float* res; float* out; const float* gate; int gate_bstride; float alpha, coef;
    __device__ __forceinline__ void operator()(const f32x4 (&acc)[2][2][4][2], const Unit& u, int wr, int wc, int fr, int fq) const {
        const int row0 = u.pm * BM + wr * 64 + fr, col0 = u.pn * BM + wc * 32 + 4 * fq;
        const float* gp = gate + (size_t)(u.pm >> 5) * gate_bstride + col0;
        f32x4 gv[2][2];
#pragma unroll
        for (int bj = 0; bj < 2; ++bj)
#pragma unroll
            for (int n = 0; n < 2; ++n) gv[bj][n] = *(const f32x4*)(gp + bj * HALF + n * 16) * coef;
#pragma unroll
        for (int ai = 0; ai < 2; ++ai)
#pragma unroll
            for (int m = 0; m < 4; ++m) { const size_t off = (size_t)(row0 + ai * HALF + m * 16) * 2048 + col0;
#pragma unroll
                for (int bj = 0; bj < 2; ++bj)
#pragma unroll
                    for (int n = 0; n < 2; ++n) { const f32x4 r = *(const f32x4*)(res + off + bj * HALF + n * 16);
                        *(f32x4*)(out + off + bj * HALF + n * 16) = r * alpha + gv[bj][n] * acc[ai][bj][m][n]; } }
    }
};
struct EpiProj {
    static constexpr bool PERM = true, AFTER_DRAIN = false;
    bf16_t* O; const float* bias;
    __device__ __forceinline__ void operator()(const f32x4 (&acc)[2][2][4][2], const Unit& u, int wr, int wc, int fr, int fq) const {
        const int row0 = u.pm * BM + wr * 64 + fr; const int colt = u.pn * BM; const int t = colt >> 10;
        bf16_t* base = O + (size_t)t * ((size_t)16384 * 1024);
        const int col0 = (colt & 1023) + wc * 32 + 8 * fq, bcol0 = colt + (colt >= 4096 ? 8 : 0) + wc * 32 + 8 * fq;
        f32x4 bv[2][2];
#pragma unroll
        for (int bj = 0; bj < 2; ++bj)
#pragma unroll
            for (int n = 0; n < 2; ++n) { const float* bp = bias + bcol0 + bj * HALF + 4 * n; bv[bj][n] = (f32x4){bp[0], bp[1], bp[2], bp[3]}; }
#pragma unroll
        for (int ai = 0; ai < 2; ++ai)
#pragma unroll
            for (int m = 0; m < 4; ++m) { bf16_t* rowp = base + (size_t)(row0 + ai * HALF + m * 16) * 1024 + col0;
#pragma unroll
                for (int bj = 0; bj < 2; ++bj) { const f32x4 v0 = acc[ai][bj][m][0] + bv[bj][0], v1 = acc[ai][bj][m][1] + bv[bj][1];
                    u32x4 w; w.x = cvt_pk_bf16(v0[0], v0[1]); w.y = cvt_pk_bf16(v0[2], v0[3]); w.z = cvt_pk_bf16(v1[0], v1[1]); w.w = cvt_pk_bf16(v1[2], v1[3]);
                    *(u32x4*)(rowp + bj * HALF) = w; } }
    }
};
template <class Epi, class Sched, bool ALIGN_EPI = false, bool SP2 = false>
__device__ __forceinline__ void gemm_phase(PG8_LAS unsigned char* lds, const Gemm g, const Sched& S, const Epi& E) {
    const int tid = otid(), wid = __builtin_amdgcn_readfirstlane(tid >> 6), lane = tid & 63, wr = wid >> 2, wc = wid & 3, fr = lane & 15, fq = lane >> 4;
    const int K = g.K, nt = K / BK;
    unsigned voffA[2], voffB[2];
#pragma unroll
    for (int i = 0; i < 2; ++i) { int R, C; stage_rc(tid * 16 + i * 8192, R, C); const int Rb = Epi::PERM ? ((R & ~31) + perm32(R & 31)) : R;
        voffA[i] = (unsigned)(R * K + C) * 2u; voffB[i] = (unsigned)(Rb * K + C) * 2u; }
    const size_t kstep = (size_t)(BK * 2);
    const size_t hstep = (size_t)HALF * K * 2;
    const size_t tstep = 2 * hstep;
    const unsigned ldsw = (unsigned)wid * 1024u;
    const int aoff = lds_byte(wr * 64 + fr, fq * 8), boff = lds_byte(wc * 32 + fr, fq * 8);
#define PG8_SA(b, h) (((b) * 2 + (h)) * HTB)
#define PG8_SB(b, h) ((4 + (b) * 2 + (h)) * HTB)
#define PG8_STAGE(bufoff, gbase, voff) do { _Pragma("unroll") for (int _i = 0; _i < 2; ++_i) \
        __builtin_amdgcn_global_load_lds((const unsigned*)((const char*)(gbase) + (voff)[_i]), (PG8_LAS unsigned*)(lds + (bufoff) + ldsw + _i * 8192), 16, 0, 0); } while (0)
#define PG8_LDA(dst, b, h) do { _Pragma("unroll") for (int m = 0; m < 4; ++m) _Pragma("unroll") for (int k = 0; k < 2; ++k) dst[m][k] = *(const PG8_LAS bf16x8*)(lds + PG8_SA(b, h) + aoff + m * 2048 + k * 1024); } while (0)
#define PG8_LDB(dst, b, h) do { _Pragma("unroll") for (int n = 0; n < 2; ++n) _Pragma("unroll") for (int k = 0; k < 2; ++k) dst[n][k] = *(const PG8_LAS bf16x8*)(lds + PG8_SB(b, h) + boff + n * 2048 + k * 1024); } while (0)
#define PG8_MMA(ai, bj, At, Bt) do { __builtin_amdgcn_s_setprio(1); _Pragma("unroll") for (int m = 0; m < 4; ++m) _Pragma("unroll") for (int n = 0; n < 2; ++n) _Pragma("unroll") for (int k = 0; k < 2; ++k) \
        acc[ai][bj][m][n] = __builtin_amdgcn_mfma_f32_16x16x32_bf16(Bt[n][k], At[m][k], acc[ai][bj][m][n], 0, 0, 0); __builtin_amdgcn_s_setprio(0); } while (0)
#define PG8_WAIT_V(n) asm volatile("s_waitcnt vmcnt(" #n ")" ::: "memory")
#define PG8_WAIT_L(n) asm volatile("s_waitcnt lgkmcnt(" #n ")" ::: "memory")
#define PG8_BAR __builtin_amdgcn_s_barrier()
#define PG8_SCHED __builtin_amdgcn_sched_barrier(0)
    Unit cur, nxt; int ui = 0;
    if (!S.next(0, cur)) return;
    f32x4 acc[2][2][4][2];
#pragma unroll
    for (int a = 0; a < 2; ++a)
#pragma unroll
        for (int b = 0; b < 2; ++b)
#pragma unroll
            for (int m = 0; m < 4; ++m)
#pragma unroll
                for (int n = 0; n < 2; ++n) acc[a][b][m][n] = (f32x4){0.f, 0.f, 0.f, 0.f};
    bf16x8 At[4][2], B0[2][2], B1[2][2];
    const char* cA = (const char*)g.A + (size_t)cur.pm * tstep; const char* cB = (const char*)g.Bt + (size_t)cur.pn * tstep;
    S.a_ready(cur);
    if constexpr (SP2) {
        PG8_STAGE(PG8_SB(0, 0), cB, voffB); PG8_STAGE(PG8_SB(0, 1), cB + hstep, voffB); PG8_STAGE(PG8_SA(0, 0), cA, voffA); PG8_STAGE(PG8_SA(0, 1), cA + hstep, voffA);
        if (wr == 1) PG8_BAR;
        PG8_WAIT_V(2); PG8_BAR;
        PG8_STAGE(PG8_SB(1, 0), cB + kstep, voffB); PG8_STAGE(PG8_SA(1, 0), cA + kstep, voffA); PG8_STAGE(PG8_SB(1, 1), cB + hstep + kstep, voffB);
        PG8_WAIT_V(6); PG8_BAR;
    } else {
        PG8_STAGE(PG8_SB(0, 0), cB, voffB); PG8_STAGE(PG8_SA(0, 0), cA, voffA); PG8_STAGE(PG8_SB(0, 1), cB + hstep, voffB); PG8_STAGE(PG8_SA(0, 1), cA + hstep, voffA);
        if (wr == 1) PG8_BAR;
        PG8_WAIT_V(4); PG8_BAR;
        PG8_STAGE(PG8_SB(1, 0), cB + kstep, voffB); PG8_STAGE(PG8_SA(1, 0), cA + kstep, voffA); PG8_STAGE(PG8_SB(1, 1), cB + hstep + kstep, voffB);
        PG8_WAIT_V(6); PG8_BAR;
    }
    for (;;) {
        const bool has_next = S.next(ui + 1, nxt);
        const char* nA = has_next ? (const char*)g.A + (size_t)nxt.pm * tstep : cA; const char* nB = has_next ? (const char*)g.Bt + (size_t)nxt.pn * tstep : cB;
        for (int t = 0; t < nt; t += 2) {
            const bool last = (t == nt - 2);
            const char* a1 = cA + (size_t)(t + 1) * kstep;
            const char* a2 = last ? nA : cA + (size_t)(t + 2) * kstep; const char* b2 = last ? nB : cB + (size_t)(t + 2) * kstep;
            const char* a3 = a2 + kstep; const char* b3 = b2 + kstep;
            if (last && has_next) S.a_ready(nxt);
            if constexpr (SP2) {
            PG8_LDB(B0, 0, 0); PG8_LDB(B1, 0, 1); PG8_SCHED; PG8_LDA(At, 0, 0); PG8_STAGE(PG8_SA(1, 1), a1 + hstep, voffA);
            PG8_WAIT_V(8); PG8_WAIT_L(0); PG8_BAR; PG8_MMA(0, 0, At, B0); PG8_MMA(0, 1, At, B1); PG8_BAR; PG8_SCHED;
            PG8_LDA(At, 0, 1); PG8_STAGE(PG8_SB(0, 0), b2, voffB); PG8_STAGE(PG8_SB(0, 1), b2 + hstep, voffB); PG8_STAGE(PG8_SA(0, 0), a2, voffA);
            PG8_WAIT_V(8); PG8_WAIT_L(0); PG8_BAR; PG8_MMA(1, 0, At, B0); PG8_MMA(1, 1, At, B1); PG8_BAR; PG8_SCHED;
            PG8_LDB(B0, 1, 0); PG8_LDB(B1, 1, 1); PG8_SCHED; PG8_LDA(At, 1, 0); PG8_STAGE(PG8_SA(0, 1), a2 + hstep, voffA);
            PG8_WAIT_V(8); PG8_WAIT_L(0); PG8_BAR; PG8_MMA(0, 0, At, B0); PG8_MMA(0, 1, At, B1); PG8_BAR; PG8_SCHED;
            PG8_LDA(At, 1, 1); PG8_STAGE(PG8_SB(1, 0), b3, voffB); PG8_STAGE(PG8_SB(1, 1), b3 + hstep, voffB); PG8_STAGE(PG8_SA(1, 0), a3, voffA);
            PG8_WAIT_V(8); PG8_WAIT_L(0); PG8_BAR; PG8_MMA(1, 0, At, B0); PG8_MMA(1, 1, At, B1); PG8_BAR; PG8_SCHED;
            } else {
            PG8_LDB(B0, 0, 0); PG8_SCHED; PG8_LDA(At, 0, 0); PG8_STAGE(PG8_SA(1, 1), a1 + hstep, voffA);
            PG8_WAIT_L(8); PG8_BAR; PG8_WAIT_L(0); PG8_MMA(0, 0, At, B0); PG8_BAR; PG8_SCHED;
            PG8_LDB(B1, 0, 1); PG8_STAGE(PG8_SB(0, 0), b2, voffB);
            PG8_BAR; PG8_WAIT_L(0); PG8_MMA(0, 1, At, B1); PG8_BAR;
            PG8_LDA(At, 0, 1); PG8_STAGE(PG8_SA(0, 0), a2, voffA);
            PG8_BAR; PG8_WAIT_L(0); PG8_MMA(1, 0, At, B0); PG8_BAR; PG8_SCHED;
            PG8_STAGE(PG8_SB(0, 1), b2 + hstep, voffB);
            PG8_WAIT_V(6); PG8_BAR; PG8_MMA(1, 1, At, B1); PG8_BAR;
            PG8_LDB(B0, 1, 0); PG8_SCHED; PG8_LDA(At, 1, 0); PG8_STAGE(PG8_SA(0, 1), a2 + hstep, voffA);
            PG8_WAIT_L(8); PG8_BAR; PG8_WAIT_L(0); PG8_MMA(0, 0, At, B0); PG8_BAR; PG8_SCHED;
            PG8_LDB(B1, 1, 1); PG8_STAGE(PG8_SB(1, 0), b3, voffB);
            PG8_BAR; PG8_WAIT_L(0); PG8_MMA(0, 1, At, B1); PG8_BAR;
            PG8_LDA(At, 1, 1); PG8_STAGE(PG8_SA(1, 0), a3, voffA);
            PG8_BAR; PG8_WAIT_L(0); PG8_MMA(1, 0, At, B0); PG8_BAR; PG8_SCHED;
            PG8_STAGE(PG8_SB(1, 1), b3 + hstep, voffB);
            PG8_WAIT_V(6); PG8_BAR; PG8_MMA(1, 1, At, B1); PG8_BAR;
            }
        }
        if constexpr (ALIGN_EPI) { if (wr == 0) PG8_BAR; }
        if constexpr (!Epi::AFTER_DRAIN) { E(acc, cur, wr, wc, fr, fq); S.done(cur); }
        if (!has_next) break;
#pragma unroll
        for (int a = 0; a < 2; ++a)
#pragma unroll
            for (int b = 0; b < 2; ++b)
#pragma unroll
                for (int m = 0; m < 4; ++m)
#pragma unroll
                    for (int n = 0; n < 2; ++n) acc[a][b][m][n] = (f32x4){0.f, 0.f, 0.f, 0.f};
        cur = nxt; cA = nA; cB = nB; ++ui;
        if constexpr (ALIGN_EPI) { if (wr == 1) PG8_BAR; }
    }
    PG8_WAIT_V(0);
    if constexpr (!ALIGN_EPI) { if (wr == 0) PG8_BAR; }
    PG8_BAR;
    if constexpr (Epi::AFTER_DRAIN) { E.fused(acc, cur, wr, wc, fr, fq, lds, wid, lane); S.done(cur); }
#undef PG8_SA
#undef PG8_SB
#undef PG8_STAGE
#undef PG8_LDA
#undef PG8_LDB
#undef PG8_MMA
#undef PG8_WAIT_V
#undef PG8_WAIT_L
#undef PG8_BAR
#undef PG8_SCHED
}
}

#define LAS __attribute__((address_space(3)))
typedef unsigned short bf16;
typedef unsigned v4u __attribute__((ext_vector_type(4)));
typedef unsigned v2u __attribute__((ext_vector_type(2)));
typedef float f32x4 __attribute__((ext_vector_type(4)));
typedef short bf16x8 __attribute__((ext_vector_type(8)));
typedef short s16x4 __attribute__((ext_vector_type(4)));

constexpr int NBATCH = 2, SEQ = 8192, M = NBATCH * SEQ, D = 2048, FF = 5632, DH = 256, NH = 4, DR = 1024;
constexpr int NMOD = 18432, INCOLS = 6152, NPROJ = 6144;
constexpr int SC = 256, NSC = SEQ / SC;
constexpr int CROWS = 272;
constexpr float ALPHA = 1.189207115002721f;
constexpr float LN_EPS = 1e-5f;
constexpr size_t MiB = (size_t)1 << 20;
constexpr size_t WS_MOD = 0, WS_ZERO_BYTES = 256 * 1024;
constexpr size_t WS_WGT = 1 * MiB, WS_GATES = 2 * MiB, WS_MDEC = 3 * MiB, WS_RGP = 4 * MiB, WS_RGH = 5 * MiB, WS_RGC = 6 * MiB;
constexpr size_t WS_WAT = 8 * MiB, WS_WXT = 8 * MiB + 512 * 1024;
constexpr size_t WS_WOUT = 9 * MiB, WS_WIN = 17 * MiB, WS_W13A = 41 * MiB, WS_W13B = 85 * MiB, WS_W2A = 129 * MiB, WS_W2B = 151 * MiB;
constexpr size_t WS_U = 173 * MiB;
constexpr size_t WS_H = 237 * MiB;
constexpr size_t WS_PROJ = 237 * MiB;
constexpr size_t WS_DC = 429 * MiB;
constexpr size_t WS_CB = 497 * MiB;
constexpr size_t WS_END = 531 * MiB;
constexpr int LDS_BYTES = 135168;

struct Params { const float* in[21]; float* out; unsigned char* ws; };
enum { I_X = 0, I_C, I_WADA, I_BADA, I_F1W13, I_F1W2, I_WIN, I_BIN, I_MNG, I_CONVW, I_CONVB, I_WA, I_BA, I_WX, I_BX, I_LAM, I_WOUT, I_F2W13, I_F2W2, I_LNG, I_LNB };

#define LDS_WAIT() asm volatile("s_waitcnt lgkmcnt(0)" ::: "memory")
__device__ __forceinline__ unsigned f2bf(float f) { unsigned u = __builtin_bit_cast(unsigned, f); return (u + 0x7fffu + ((u >> 16) & 1u)) >> 16; }
__device__ __forceinline__ unsigned pk2(float lo, float hi) { return f2bf(lo) | (f2bf(hi) << 16); }
__device__ __forceinline__ float bflo(unsigned w) { return __builtin_bit_cast(float, w << 16); }
__device__ __forceinline__ float bfhi(unsigned w) { return __builtin_bit_cast(float, w & 0xffff0000u); }
__device__ __forceinline__ float wave_sum(float v) {
#pragma unroll
    for (int o = 1; o < 64; o <<= 1) v += __shfl_xor(v, o);
    return v;
}
__device__ __forceinline__ float sigm(float x) { return 1.0f / (1.0f + __expf(-x)); }
__device__ __forceinline__ float logsigm(float x) { return x < 0.f ? x - log1pf(__expf(x)) : -log1pf(__expf(-x)); }
__device__ __forceinline__ s16x4 tr_read(LAS unsigned char* p) {
    typedef short v4i16_t __attribute__((ext_vector_type(4)));
    return __builtin_bit_cast(s16x4, __builtin_amdgcn_ds_read_tr16_b64_v4i16((LAS v4i16_t*)p));
}
__device__ __forceinline__ bf16x8 cat8(s16x4 lo, s16x4 hi) { return __builtin_shufflevector(lo, hi, 0, 1, 2, 3, 4, 5, 6, 7); }
#define MFMA16(a, b, c) __builtin_amdgcn_mfma_f32_16x16x32_bf16((a), (b), (c), 0, 0, 0)

__device__ __forceinline__ void tr_item(const float* __restrict__ W, int ldw, int K, int src_col, bf16* __restrict__ WT, int dst_row, int k0, LAS float* scr, int lane) {
#pragma unroll 8
    for (int i = 0; i < 32; ++i) { const int kk = 2 * i + (lane >> 5); scr[kk * 33 + (lane & 31)] = W[(size_t)(k0 + kk) * ldw + src_col + (lane & 31)]; }
    LDS_WAIT();
    const int c = lane & 7;
#pragma unroll
    for (int j = 0; j < 4; ++j) { const int n = (lane >> 3) + 8 * j; const LAS float* s = scr + (8 * c) * 33 + n;
        v4u o; o.x = pk2(s[0 * 33], s[1 * 33]); o.y = pk2(s[2 * 33], s[3 * 33]); o.z = pk2(s[4 * 33], s[5 * 33]); o.w = pk2(s[6 * 33], s[7 * 33]);
        *(v4u*)(WT + (size_t)(dst_row + n) * K + k0 + 8 * c) = o; }
    LDS_WAIT();
}
__device__ __forceinline__ void p0_prologue(const Params& p, LAS unsigned char* lds) {
    const int tid = otid(), lane = tid & 63, wave = tid >> 6;
    unsigned char* ws = p.ws;
    LAS float* scr = (LAS float*)(lds + wave * 16384);
    const int gw = blockIdx.x * 8 + wave, NGW = gridDim.x * 8;
    constexpr int I_13 = 32 * 352, I_2 = 88 * 64, I_IN = 32 * 192, I_OUT = 32 * 64, I_RG = 64;
    constexpr int NITEMS = 2 * I_13 + 2 * I_2 + I_IN + I_OUT + 2 * I_RG;
    for (int it = gw; it < NITEMS; it += NGW) {
        int r = it;
        if (r < 2 * I_13) { const int which = r >= I_13; r -= which * I_13; const int kb = r / 352, nb = r % 352, n0 = 32 * nb, pt = n0 >> 8, rr = n0 & 255;
            const int sc = rr < 128 ? 128 * pt + rr : FF + 128 * pt + (rr - 128);
            tr_item(p.in[which ? I_F2W13 : I_F1W13], 2 * FF, D, sc, (bf16*)(ws + (which ? WS_W13B : WS_W13A)), n0, 64 * kb, scr, lane); continue; }
        r -= 2 * I_13;
        if (r < 2 * I_2) { const int which = r >= I_2; r -= which * I_2; const int kb = r >> 6, nb = r & 63;
            tr_item(p.in[which ? I_F2W2 : I_F1W2], D, FF, 32 * nb, (bf16*)(ws + (which ? WS_W2B : WS_W2A)), 32 * nb, 64 * kb, scr, lane); continue; }
        r -= 2 * I_2;
        if (r < I_IN) { const int kb = r / 192, nb = r % 192, n0 = 32 * nb;
            tr_item(p.in[I_WIN], INCOLS, D, n0 < 4096 ? n0 : n0 + 8, (bf16*)(ws + WS_WIN), n0, 64 * kb, scr, lane); continue; }
        r -= I_IN;
        if (r < I_OUT) { const int kb = r >> 6, nb = r & 63;
            tr_item(p.in[I_WOUT], D, D, 32 * nb, (bf16*)(ws + WS_WOUT), 32 * nb, 64 * kb, scr, lane); continue; }
        r -= I_OUT;
        { const int which = r >= I_RG; r -= which * I_RG; const int blk = r >> 3, l = r & 7, kb = l >> 2, nb = l & 3;
            tr_item(p.in[which ? I_WX : I_WA] + blk * 16384, 128, 128, 32 * nb, (bf16*)(ws + (which ? WS_WXT : WS_WAT)) + blk * 16384, 32 * nb, 64 * kb, scr, lane); }
    }
    __syncthreads();
    LAS float* sc = (LAS float*)lds;
    for (int i = tid; i < NBATCH * D; i += 512) { const float cv = p.in[I_C][i]; sc[i] = cv / (1.0f + __expf(-cv)); }
    __syncthreads();
    const int gid = blockIdx.x * 512 + tid;
    float* mod = (float*)(ws + WS_MOD);
    for (int it = gid; it < 16 * (NMOD / 4); it += gridDim.x * 512) {
        const int cgp = it % (NMOD / 4), kc = it / (NMOD / 4);
        const f32x4* wp = (const f32x4*)(p.in[I_WADA] + (size_t)(kc * 128) * NMOD) + cgp;
        f32x4 a0 = {0.f, 0.f, 0.f, 0.f}, a1 = {0.f, 0.f, 0.f, 0.f};
#pragma unroll 8
        for (int k = 0; k < 128; ++k) { const f32x4 w = wp[(size_t)k * (NMOD / 4)]; a0 += w * sc[kc * 128 + k]; a1 += w * sc[D + kc * 128 + k]; }
        if (kc == 0) { const f32x4 b4 = ((const f32x4*)p.in[I_BADA])[cgp]; a0 += b4; a1 += b4; }
#pragma unroll
        for (int i = 0; i < 4; ++i) { atomicAdd(mod + 4 * cgp + i, a0[i]); atomicAdd(mod + NMOD + 4 * cgp + i, a1[i]); }
    }
    for (int it = gid; it < 8 * D; it += gridDim.x * 512) { const int g = it >> 11, k = it & 2047; ((float*)(ws + WS_WGT))[it] = p.in[I_WIN][(size_t)k * INCOLS + 4096 + g]; }
    __syncthreads();
}

__device__ __forceinline__ void row_pass(const Params& p, const float* src, float* dstx, int ln_idx  , int mod_idx  , bool do_gates) {
    const int tid = otid(), lane = tid & 63, wave = tid >> 6;
    const int gw = blockIdx.x * 8 + wave, NGW = gridDim.x * 8;
    const float* mod = (const float*)(p.ws + WS_MOD);
    bf16* U = (bf16*)(p.ws + WS_U);
    for (int m = gw; m < M; m += NGW) {
        const int b = m >> 13;
        const f32x4* xr = (const f32x4*)(src + (size_t)m * D) + lane;
        f32x4 v[8]; float s = 0.f;
#pragma unroll
        for (int j = 0; j < 8; ++j) { v[j] = xr[64 * j]; s += (v[j].x + v[j].y) + (v[j].z + v[j].w); }
        float mean = wave_sum(s) * (1.f / D), s2 = 0.f;
#pragma unroll
        for (int j = 0; j < 8; ++j) { v[j] = v[j] - mean; s2 += (v[j].x * v[j].x + v[j].y * v[j].y) + (v[j].z * v[j].z + v[j].w * v[j].w); }
        float rstd = 1.0f / sqrtf(wave_sum(s2) * (1.f / D) + LN_EPS);
        if (ln_idx >= 0) {
            const f32x4* g4 = (const f32x4*)(p.in[I_LNG] + ln_idx * D) + lane; const f32x4* b4 = (const f32x4*)(p.in[I_LNB] + ln_idx * D) + lane;
            f32x4* xo = (f32x4*)(dstx + (size_t)m * D) + lane; s = 0.f;
#pragma unroll
            for (int j = 0; j < 8; ++j) { v[j] = v[j] * rstd * g4[64 * j] + b4[64 * j]; xo[64 * j] = v[j]; s += (v[j].x + v[j].y) + (v[j].z + v[j].w); }
            if (mod_idx < 0) continue;
            mean = wave_sum(s) * (1.f / D); s2 = 0.f;
#pragma unroll
            for (int j = 0; j < 8; ++j) { v[j] = v[j] - mean; s2 += (v[j].x * v[j].x + v[j].y * v[j].y) + (v[j].z * v[j].z + v[j].w * v[j].w); }
            rstd = 1.0f / sqrtf(wave_sum(s2) * (1.f / D) + LN_EPS);
        }
        const f32x4* sh4 = (const f32x4*)(mod + (size_t)b * NMOD + mod_idx * 3 * D) + lane; const f32x4* sc4 = sh4 + D / 4;
        v2u* uo = (v2u*)(U + (size_t)m * D) + lane;
#pragma unroll
        for (int j = 0; j < 8; ++j) { v[j] = v[j] * rstd * (sc4[64 * j] + 1.0f) + sh4[64 * j]; v2u w; w.x = pk2(v[j].x, v[j].y); w.y = pk2(v[j].z, v[j].w); uo[64 * j] = w; }
        if (do_gates) {
            const float* wgt = (const float*)(p.ws + WS_WGT); float* gates = (float*)(p.ws + WS_GATES);
#pragma unroll 1
            for (int g = 0; g < 8; ++g) { const f32x4* w4 = (const f32x4*)(wgt + g * D) + lane; float d = 0.f;
#pragma unroll
                for (int j = 0; j < 8; ++j) { const f32x4 w = w4[64 * j]; d += (v[j].x * w.x + v[j].y * w.y) + (v[j].z * w.z + v[j].w * w.w); }
                d = wave_sum(d); if (lane == 0) gates[(size_t)m * 8 + g] = d + p.in[I_BIN][4096 + g]; }
        }
    }
}

constexpr int L_KT = 0, KT_PITCH = 528;
constexpr int L_VT = 33792, VT_PITCH = 560;
constexpr int L_GB = 69632, L_GLI = 70656, L_GM = 71680, L_GW = 72704;
constexpr int L_PA = 73728, L_PB = 75776, L_MISC = 77824;

__device__ __forceinline__ void mlstm_gates(const float* __restrict__ gates, int b, int h, int j, LAS unsigned char* lds) {
    const int tid = otid(), lane = tid & 63, wave = tid >> 6;
    LAS float* GB = (LAS float*)(lds + L_GB); LAS float* GLI = (LAS float*)(lds + L_GLI); LAS float* GM = (LAS float*)(lds + L_GM);
    LAS float* PA = (LAS float*)(lds + L_PA); LAS float* PB = (LAS float*)(lds + L_PB); LAS float* MISC = (LAS float*)(lds + L_MISC);
    const float NEG = -__builtin_inff();
    float A = 0.f, B = NEG;
    if (16 * tid < SC * j) {
        const float* gp = gates + ((size_t)b * SEQ + 16 * tid) * 8;
#pragma unroll 4
        for (int i = 0; i < 16; ++i) { const float li = gp[i * 8 + h], lf = logsigm(gp[i * 8 + 4 + h]); A += lf; B = fmaxf(B + lf, li); }
    }
    PA[tid] = A; PB[tid] = B;
    __syncthreads();
    if (wave == 0) {
        A = 0.f; B = NEG;
#pragma unroll
        for (int i = 0; i < 8; ++i) { const float a = PA[8 * lane + i], bb = PB[8 * lane + i]; B = fmaxf(B + a, bb); A += a; }
#pragma unroll
        for (int o = 1; o < 64; o <<= 1) { const float Ap = __shfl_up(A, o), Bp = __shfl_up(B, o); if (lane >= o) { B = fmaxf(Bp + A, B); A = Ap + A; } }
        const float mend = fmaxf(A, B);
        float ms = __shfl(mend, (2 * j - 1) & 63); if (j == 0) ms = 0.f;
        const float* gp = gates + ((size_t)b * SEQ + SC * j + 4 * lane) * 8;
        float li[4], lf[4], cs[4];
#pragma unroll
        for (int i = 0; i < 4; ++i) { li[i] = gp[i * 8 + h]; lf[i] = logsigm(gp[i * 8 + 4 + h]); }
        cs[0] = lf[0]; cs[1] = cs[0] + lf[1]; cs[2] = cs[1] + lf[2]; cs[3] = cs[2] + lf[3];
        float incl = cs[3];
#pragma unroll
        for (int o = 1; o < 64; o <<= 1) { const float t = __shfl_up(incl, o); if (lane >= o) incl += t; }
        const float excl = incl - cs[3];
        float LA = cs[3], LB = NEG;
#pragma unroll
        for (int i = 0; i < 4; ++i) LB = fmaxf(LB + lf[i], li[i]);
#pragma unroll
        for (int o = 1; o < 64; o <<= 1) { const float Ap = __shfl_up(LA, o), Bp = __shfl_up(LB, o); if (lane >= o) { LB = fmaxf(Bp + LA, LB); LA = Ap + LA; } }
        const float Ae = __shfl_up(LA, 1), Be = __shfl_up(LB, 1);
        float mp = (lane == 0) ? ms : fmaxf(ms + Ae, Be);
#pragma unroll
        for (int i = 0; i < 4; ++i) { mp = fmaxf(mp + lf[i], li[i]); GB[4 * lane + i] = excl + cs[i]; GLI[4 * lane + i] = li[i]; GM[4 * lane + i] = mp; }
        if (lane == 0) MISC[0] = ms;
    }
    __syncthreads();
}
__device__ __forceinline__ void stage_rows(const bf16* __restrict__ src  , LAS unsigned char* dst, int pitch, const LAS float* scale) {
    const int tid = otid();
#pragma unroll
    for (int i = 0; i < 4; ++i) { const int c = tid + 512 * i, r = c >> 5, ch = c & 31;
        v4u x = *(const v4u*)(src + (size_t)r * DR + 8 * ch);
        if (scale) { const float w = scale[r];
            x.x = pk2(bflo(x.x) * w, bfhi(x.x) * w); x.y = pk2(bflo(x.y) * w, bfhi(x.y) * w); x.z = pk2(bflo(x.z) * w, bfhi(x.z) * w); x.w = pk2(bflo(x.w) * w, bfhi(x.w) * w); }
        *(LAS v4u*)(dst + r * pitch + 16 * ch) = x; }
}
__device__ __forceinline__ void preset_ones_col(LAS unsigned char* lds) {
    const int tid = otid();
    if (tid < 128) { const int r = tid >> 1, hf = tid & 1; v4u z = {0u, 0u, 0u, 0u}; if (!hf) z.x = 0x3F80u; *(LAS v4u*)(lds + L_VT + r * VT_PITCH + 512 + 16 * hf) = z; }
}
__device__ __forceinline__ void m1_unit(const Params& p, int bh, int j, LAS unsigned char* lds) {
    const int tid = otid(), lane = tid & 63, wave = tid >> 6, b = bh >> 2, h = bh & 3;
    LAS float* GB = (LAS float*)(lds + L_GB); LAS float* GLI = (LAS float*)(lds + L_GLI); LAS float* GM = (LAS float*)(lds + L_GM); LAS float* GW = (LAS float*)(lds + L_GW);
    LAS float* MISC = (LAS float*)(lds + L_MISC);
    mlstm_gates((const float*)(p.ws + WS_GATES), b, h, j, lds);
    const float b_last = GB[SC - 1], m_end = GM[SC - 1], m_start = MISC[0];
    if (tid < SC) GW[tid] = __expf(b_last - GB[tid] + GLI[tid] - m_end) * 0.0625f;
    if (tid == 0) ((float*)(p.ws + WS_MDEC))[bh * NSC + j] = __expf(b_last + m_start - m_end);
    preset_ones_col(lds);
    __syncthreads();
    const bf16* Kp = (const bf16*)(p.ws + WS_PROJ) + (size_t)1 * M * DR + ((size_t)b * SEQ + SC * j) * DR + h * DH;
    const bf16* Vp = (const bf16*)(p.ws + WS_PROJ) + (size_t)2 * M * DR + ((size_t)b * SEQ + SC * j) * DR + h * DH;
    f32x4 acc[17][2];
#pragma unroll
    for (int mt = 0; mt < 17; ++mt) { acc[mt][0] = (f32x4){0.f, 0.f, 0.f, 0.f}; acc[mt][1] = (f32x4){0.f, 0.f, 0.f, 0.f}; }
#pragma unroll 1
    for (int sb = 0; sb < 4; ++sb) {
        int g = lane >> 4, q = (lane & 15) >> 2, pp = lane & 3; asm volatile("" : "+v"(g), "+v"(q), "+v"(pp));
        stage_rows(Kp + (size_t)(64 * sb) * DR, lds + L_KT, KT_PITCH, GW + 64 * sb);
        stage_rows(Vp + (size_t)(64 * sb) * DR, lds + L_VT, VT_PITCH, nullptr);
        __syncthreads();
#pragma unroll
        for (int ks = 0; ks < 2; ++ks) {
            const int rowoff = 32 * ks + 8 * g + q;
            LAS unsigned char* kb = lds + L_KT + rowoff * KT_PITCH + (32 * wave + 4 * pp) * 2;
            const bf16x8 b0 = cat8(tr_read(kb), tr_read(kb + 4 * KT_PITCH)), b1 = cat8(tr_read(kb + 32), tr_read(kb + 32 + 4 * KT_PITCH));
            LAS unsigned char* vb = lds + L_VT + rowoff * VT_PITCH + (4 * pp) * 2;
#pragma unroll
            for (int mt = 0; mt < 17; ++mt) { const bf16x8 a = cat8(tr_read(vb + 32 * mt), tr_read(vb + 32 * mt + 4 * VT_PITCH));
                acc[mt][0] = MFMA16(a, b0, acc[mt][0]); acc[mt][1] = MFMA16(a, b1, acc[mt][1]); if (mt & 1) asm volatile("" ::: "memory"); }
        }
        __syncthreads();
    }
    float* dc = (float*)(p.ws + WS_DC) + (size_t)(bh * NSC + j) * CROWS * DH;
#pragma unroll
    for (int mt = 0; mt < 17; ++mt) {
        int ro = (4 * (lane >> 4)) * DH + 32 * wave + (lane & 15); asm volatile("" : "+v"(ro));
        float* dp = dc + (size_t)(16 * mt) * DH + ro;
#pragma unroll
        for (int nl = 0; nl < 2; ++nl)
#pragma unroll
            for (int i = 0; i < 4; ++i) dp[i * DH + 16 * nl] = acc[mt][nl][i]; }
}
__device__ __forceinline__ void m2_scan(const Params& p) {
    const float* __restrict__ dc = (const float*)(p.ws + WS_DC); bf16* __restrict__ cb = (bf16*)(p.ws + WS_CB); const float* __restrict__ dec = (const float*)(p.ws + WS_MDEC);
    constexpr int PER = CROWS * DH / 4;
    for (int it = blockIdx.x * 512 + otid(); it < 8 * PER; it += gridDim.x * 512) {
        const int bh = it / PER, idx = it % PER;
        const f32x4* src = (const f32x4*)(dc + (size_t)bh * NSC * CROWS * DH) + idx; v2u* dst = (v2u*)(cb + (size_t)bh * NSC * CROWS * DH) + idx;
        f32x4 C = {0.f, 0.f, 0.f, 0.f};
#pragma unroll 8
        for (int j = 0; j < NSC; ++j) { const f32x4 d = src[(size_t)j * PER]; v2u w; w.x = pk2(C.x, C.y); w.y = pk2(C.z, C.w); dst[(size_t)j * PER] = w; C = C * dec[bh * NSC + j] + d; }
    }
}
__device__ __forceinline__ void m3_unit(const Params& p, int bh, int j, LAS unsigned char* lds) {
    const int tid = otid(), lane = tid & 63, wave = tid >> 6, b = bh >> 2, h = bh & 3;
    const int pp = lane & 3;
    LAS float* GB = (LAS float*)(lds + L_GB); LAS float* GLI = (LAS float*)(lds + L_GLI); LAS float* GM = (LAS float*)(lds + L_GM); LAS float* MISC = (LAS float*)(lds + L_MISC);
    mlstm_gates((const float*)(p.ws + WS_GATES), b, h, j, lds);
    const float m_start = MISC[0];
    preset_ones_col(lds);
    const size_t tokbase = (size_t)b * SEQ + SC * j;
    const bf16* Qp = (const bf16*)(p.ws + WS_PROJ) + tokbase * DR + h * DH;
    const bf16* Kp = (const bf16*)(p.ws + WS_PROJ) + (size_t)1 * M * DR + tokbase * DR + h * DH;
    const bf16* Vp = (const bf16*)(p.ws + WS_PROJ) + (size_t)2 * M * DR + tokbase * DR + h * DH;
    const bf16* Op = (const bf16*)(p.ws + WS_PROJ) + (size_t)3 * M * DR + tokbase * DR + h * DH;
    const bf16* cb = (const bf16*)(p.ws + WS_CB) + (size_t)(bh * NSC + j) * CROWS * DH;
    bf16* Y = (bf16*)(p.ws + WS_U) + tokbase * D + h * DH;
    const float* ng = p.in[I_MNG] + h * DH;
#pragma unroll 1
    for (int ps = 0; ps < 2; ++ps) {
        int l15 = lane & 15, g = lane >> 4; asm volatile("" : "+v"(l15), "+v"(g));
        const int q = l15 >> 2;
        const int t0 = 128 * ps + 16 * wave, tl = t0 + l15;
        bf16x8 bq[8];
#pragma unroll
        for (int ks = 0; ks < 8; ++ks) bq[ks] = *(const bf16x8*)(Qp + (size_t)tl * DR + 32 * ks + 8 * g);
        f32x4 acc[17];
#pragma unroll
        for (int mt = 0; mt < 17; ++mt) acc[mt] = (f32x4){0.f, 0.f, 0.f, 0.f};
#pragma unroll
        for (int mt = 0; mt < 17; ++mt) {
#pragma unroll
            for (int ks = 0; ks < 8; ++ks) { const bf16x8 a = *(const bf16x8*)(cb + (size_t)(16 * mt + l15) * DH + 32 * ks + 8 * g); acc[mt] = MFMA16(a, bq[ks], acc[mt]); }
            asm volatile("" ::: "memory"); }
        const float bt = GB[tl], mt_ = GM[tl];
        const float winter = __expf(bt + m_start - mt_);
#pragma unroll
        for (int mt = 0; mt < 17; ++mt) acc[mt] = acc[mt] * winter;
        for (int kb = 0; kb < 2 * ps + 2; ++kb) {
            __syncthreads();
            stage_rows(Kp + (size_t)(64 * kb) * DR, lds + L_KT, KT_PITCH, nullptr);
            stage_rows(Vp + (size_t)(64 * kb) * DR, lds + L_VT, VT_PITCH, nullptr);
            __syncthreads();
            if (64 * kb <= t0 + 15) {
#pragma unroll 1
                for (int sub = 0; sub < 2; ++sub) {
                    const int s0 = 64 * kb + 32 * sub;
                    if (s0 > t0 + 15) break;
                    f32x4 sa = {0.f, 0.f, 0.f, 0.f}, sb = {0.f, 0.f, 0.f, 0.f};
                    LAS unsigned char* kr = lds + L_KT + (32 * sub + l15) * KT_PITCH + 16 * g;
#pragma unroll
                    for (int ks = 0; ks < 8; ++ks) { const bf16x8 ka = *(const LAS bf16x8*)(kr + 64 * ks), kb2 = *(const LAS bf16x8*)(kr + 16 * KT_PITCH + 64 * ks);
                        sa = MFMA16(ka, bq[ks], sa); sb = MFMA16(kb2, bq[ks], sb); }
                    float pa[4], pb[4];
#pragma unroll
                    for (int i = 0; i < 4; ++i) { const int s1 = s0 + 4 * g + i, s2 = s1 + 16;
                        const float w1 = (s1 <= tl) ? __expf(bt - GB[s1] + GLI[s1] - mt_) * 0.0625f : 0.f;
                        const float w2 = (s2 <= tl) ? __expf(bt - GB[s2] + GLI[s2] - mt_) * 0.0625f : 0.f;
                        pa[i] = sa[i] * w1; pb[i] = sb[i] * w2; }
                    v4u pw; pw.x = pk2(pa[0], pa[1]); pw.y = pk2(pa[2], pa[3]); pw.z = pk2(pb[0], pb[1]); pw.w = pk2(pb[2], pb[3]);
                    const bf16x8 pf = __builtin_bit_cast(bf16x8, pw);
                    LAS unsigned char* vb = lds + L_VT + (32 * sub + 4 * g + q) * VT_PITCH + (4 * pp) * 2;
#pragma unroll
                    for (int mt = 0; mt < 17; ++mt) { const bf16x8 a = cat8(tr_read(vb + 32 * mt), tr_read(vb + 32 * mt + 16 * VT_PITCH)); acc[mt] = MFMA16(a, pf, acc[mt]); if ((mt & 3) == 3) asm volatile("" ::: "memory"); }
                }
            }
        }
        const float den = __shfl(acc[16][0], l15);
        const float inv = 1.0f / fmaxf(fabsf(den), __expf(-mt_));
        float s = 0.f;
#pragma unroll
        for (int mt = 0; mt < 16; ++mt) { acc[mt] = acc[mt] * inv; s += (acc[mt][0] + acc[mt][1]) + (acc[mt][2] + acc[mt][3]); }
        s += __shfl_xor(s, 16); s += __shfl_xor(s, 32);
        const float mean = s * (1.f / DH); float s2 = 0.f;
#pragma unroll
        for (int mt = 0; mt < 16; ++mt) { acc[mt] = acc[mt] - mean; s2 += (acc[mt][0] * acc[mt][0] + acc[mt][1] * acc[mt][1]) + (acc[mt][2] * acc[mt][2] + acc[mt][3] * acc[mt][3]); }
        s2 += __shfl_xor(s2, 16); s2 += __shfl_xor(s2, 32);
        const float rstd = 1.0f / sqrtf(s2 * (1.f / DH) + LN_EPS);
#pragma unroll
        for (int mt = 0; mt < 16; ++mt) { const int e = 16 * mt + 4 * g;
            const f32x4 g4 = *(const f32x4*)(ng + e); const v2u o2 = *(const v2u*)(Op + (size_t)tl * DR + e);
            const float y0 = acc[mt][0] * rstd * g4.x * sigm(bflo(o2.x)), y1 = acc[mt][1] * rstd * g4.y * sigm(bfhi(o2.x));
            const float y2 = acc[mt][2] * rstd * g4.z * sigm(bflo(o2.y)), y3 = acc[mt][3] * rstd * g4.w * sigm(bfhi(o2.y));
            v2u w; w.x = pk2(y0, y1); w.y = pk2(y2, y3); *(v2u*)(Y + (size_t)tl * D + e) = w; }
    }
    __syncthreads();
}

constexpr int L_XC = 0, XC_PITCH = 272;
constexpr int L_AS = 17408, L_US = 51200, AU_PITCH = 132;
__device__ __forceinline__ float gelu_tanh(float x) { const float z = 0.7978845608028654f * (x + 0.044715f * x * x * x); const float t = 1.0f - 2.0f / (1.0f + __expf(2.0f * z)); return 0.5f * x * (1.0f + t); }
__device__ __forceinline__ void rg_unit(const Params& p, int tile, int blk, int pass, LAS unsigned char* lds) {
    const int tid = otid(), lane = tid & 63, wave = tid >> 6, g = lane >> 4, l15 = lane & 15;
    const bf16* XR = (const bf16*)(p.ws + WS_PROJ) + (size_t)4 * M * DR; const bf16* GR = (const bf16*)(p.ws + WS_PROJ) + (size_t)5 * M * DR;
    LAS float* AS = (LAS float*)(lds + L_AS); LAS float* US = (LAS float*)(lds + L_US);
    const int tok0 = tile * 64;
    {
        const int t = tid >> 3, c8 = tid & 7, tok = tok0 + t, tseq = tok & (SEQ - 1);
#pragma unroll
        for (int hf = 0; hf < 2; ++hf) { const int c0 = blk * 128 + 16 * c8 + 8 * hf;
            float a[8]; { const f32x4 b0 = *(const f32x4*)(p.in[I_CONVB] + c0), b1 = *(const f32x4*)(p.in[I_CONVB] + c0 + 4); a[0] = b0.x; a[1] = b0.y; a[2] = b0.z; a[3] = b0.w; a[4] = b1.x; a[5] = b1.y; a[6] = b1.z; a[7] = b1.w; }
#pragma unroll
            for (int tap = 0; tap < 4; ++tap) { if (tseq - 3 + tap >= 0) {
                const v4u x = *(const v4u*)(XR + (size_t)(tok - 3 + tap) * DR + c0);
                const f32x4 w0 = *(const f32x4*)(p.in[I_CONVW] + tap * DR + c0), w1 = *(const f32x4*)(p.in[I_CONVW] + tap * DR + c0 + 4);
                a[0] += bflo(x.x) * w0.x; a[1] += bfhi(x.x) * w0.y; a[2] += bflo(x.y) * w0.z; a[3] += bfhi(x.y) * w0.w;
                a[4] += bflo(x.z) * w1.x; a[5] += bfhi(x.z) * w1.y; a[6] += bflo(x.w) * w1.z; a[7] += bfhi(x.w) * w1.w; } }
            v4u o; o.x = pk2(a[0], a[1]); o.y = pk2(a[2], a[3]); o.z = pk2(a[4], a[5]); o.w = pk2(a[6], a[7]);
            *(LAS v4u*)(lds + L_XC + t * XC_PITCH + (16 * c8 + 8 * hf) * 2) = o; }
    }
    __syncthreads();
    {
        const bf16* wa = (const bf16*)(p.ws + WS_WAT) + blk * 16384 + (16 * wave + l15) * 128 + 8 * g;
        const bf16* wx = (const bf16*)(p.ws + WS_WXT) + blk * 16384 + (16 * wave + l15) * 128 + 8 * g;
        bf16x8 fa[4], fx[4];
#pragma unroll
        for (int ks = 0; ks < 4; ++ks) { fa[ks] = *(const bf16x8*)(wa + 32 * ks); fx[ks] = *(const bf16x8*)(wx + 32 * ks); }
        f32x4 ar[4], ai[4];
#pragma unroll
        for (int mt = 0; mt < 4; ++mt) { ar[mt] = (f32x4){0.f, 0.f, 0.f, 0.f}; ai[mt] = (f32x4){0.f, 0.f, 0.f, 0.f};
#pragma unroll
            for (int ks = 0; ks < 4; ++ks) { const bf16x8 a = *(const LAS bf16x8*)(lds + L_XC + (16 * mt + l15) * XC_PITCH + 64 * ks + 16 * g);
                ar[mt] = MFMA16(a, fa[ks], ar[mt]); ai[mt] = MFMA16(a, fx[ks], ai[mt]); } }
        const int c = 16 * wave + l15, ch = blk * 128 + c;
        const float bav = p.in[I_BA][ch], bxv = p.in[I_BX][ch], lam = p.in[I_LAM][ch];
        const float sp8 = 8.0f * log1pf(__expf(-lam));
#pragma unroll
        for (int mt = 0; mt < 4; ++mt)
#pragma unroll
            for (int i = 0; i < 4; ++i) { const int t = 16 * mt + 4 * g + i;
                const float r = sigm(ar[mt][i] + bav), ig = sigm(ai[mt][i] + bxv), la = -sp8 * r, a = __expf(la), mult = sqrtf(-expm1f(2.0f * la));
                const float xcv = __builtin_bit_cast(float, (unsigned)(*(const LAS unsigned short*)(lds + L_XC + t * XC_PITCH + 2 * c)) << 16);
                AS[t * AU_PITCH + c] = a; US[t * AU_PITCH + c] = mult * ig * xcv; }
    }
    __syncthreads();
    if (tid < 128) {
        const int ch = blk * 128 + tid;
        if (pass == 0) { float P = 1.f, hh = 0.f;
#pragma unroll 8
            for (int t = 0; t < 64; ++t) { const float a = AS[t * AU_PITCH + tid]; hh = a * hh + US[t * AU_PITCH + tid]; P *= a; }
            ((float*)(p.ws + WS_RGP))[(size_t)tile * DR + ch] = P; ((float*)(p.ws + WS_RGH))[(size_t)tile * DR + ch] = hh;
        } else { float hh = ((const float*)(p.ws + WS_RGC))[(size_t)tile * DR + ch];
#pragma unroll 8
            for (int t = 0; t < 64; ++t) { hh = AS[t * AU_PITCH + tid] * hh + US[t * AU_PITCH + tid]; US[t * AU_PITCH + tid] = hh; } }
    }
    if (pass == 1) {
        __syncthreads();
        const int t = tid >> 3, c8 = tid & 7, tok = tok0 + t;
        bf16* Y = (bf16*)(p.ws + WS_U) + (size_t)tok * D + DR + blk * 128 + 16 * c8;
#pragma unroll
        for (int hf = 0; hf < 2; ++hf) { const v4u gq = *(const v4u*)(GR + (size_t)tok * DR + blk * 128 + 16 * c8 + 8 * hf);
            const LAS float* hp = US + t * AU_PITCH + 16 * c8 + 8 * hf;
            v4u o; o.x = pk2(hp[0] * gelu_tanh(bflo(gq.x)), hp[1] * gelu_tanh(bfhi(gq.x))); o.y = pk2(hp[2] * gelu_tanh(bflo(gq.y)), hp[3] * gelu_tanh(bfhi(gq.y)));
            o.z = pk2(hp[4] * gelu_tanh(bflo(gq.z)), hp[5] * gelu_tanh(bfhi(gq.z))); o.w = pk2(hp[6] * gelu_tanh(bflo(gq.w)), hp[7] * gelu_tanh(bfhi(gq.w)));
            *(v4u*)(Y + 8 * hf) = o; }
    }
    __syncthreads();
}
__device__ __forceinline__ void rg_carry_unit(const Params& p, int unit, LAS unsigned char* lds) {
    const int tid = otid(), b = unit >> 4, cg0 = (unit & 15) * 64;
    LAS float* Pl = (LAS float*)lds; LAS float* Hl = (LAS float*)(lds + 32768);
    const float* RP = (const float*)(p.ws + WS_RGP); const float* RH = (const float*)(p.ws + WS_RGH); float* RC = (float*)(p.ws + WS_RGC);
    for (int i = tid; i < 128 * 64; i += 512) { const int tl = i >> 6, c = i & 63; const size_t o = (size_t)(b * 128 + tl) * DR + cg0 + c; Pl[i] = RP[o]; Hl[i] = RH[o]; }
    __syncthreads();
    if (tid < 64) { float carry = 0.f;
        for (int tl = 0; tl < 128; ++tl) { const float cp = Pl[tl * 64 + tid], chh = Hl[tl * 64 + tid]; Pl[tl * 64 + tid] = carry; carry = cp * carry + chh; } }
    __syncthreads();
    for (int i = tid; i < 128 * 64; i += 512) { const int tl = i >> 6, c = i & 63; RC[(size_t)(b * 128 + tl) * DR + cg0 + c] = Pl[i]; }
    __syncthreads();
}

__global__ void __launch_bounds__(512, 2) hybrid_fwd(Params p) {
    extern __shared__ __attribute__((aligned(16))) unsigned char lds_raw[];
    LAS unsigned char* lds = (LAS unsigned char*)lds_raw;
    cg::grid_group grid = cg::this_grid();
    unsigned char* ws = p.ws;
    const int G = gridDim.x, bid = blockIdx.x;
    const float* mod = (const float*)(ws + WS_MOD);
    bf16* U = (bf16*)(ws + WS_U); bf16* Hb = (bf16*)(ws + WS_H);
    float* XB = p.out;

    p0_prologue(p, lds);
    grid.sync();
    row_pass(p, p.in[I_X], nullptr, -1, 0, false);
    grid.sync();
    { pg8::Gemm gm{U, (const bf16*)(ws + WS_W13A), M, 2 * FF, D}; pg8::StaticOrder S; S.init(M, 2 * FF, G, bid);
      pg8::EpiSwiglu E{Hb, FF}; pg8::gemm_phase<pg8::EpiSwiglu, pg8::StaticOrder, true, true>(lds, gm, S, E); }
    grid.sync();
    { pg8::Gemm gm{Hb, (const bf16*)(ws + WS_W2A), M, D, FF}; pg8::StaticOrder S; S.init(M, D, G, bid);
      pg8::EpiRes E{p.in[I_X], XB, mod + 0 * 3 * D + 2 * D, NMOD, ALPHA, 0.5f}; pg8::gemm_phase<pg8::EpiRes, pg8::StaticOrder, true, true>(lds, gm, S, E); }
    grid.sync();
    row_pass(p, XB, XB, 0, 1, true);
    grid.sync();
    { pg8::Gemm gm{U, (const bf16*)(ws + WS_WIN), M, NPROJ, D}; pg8::StaticOrder S; S.init(M, NPROJ, G, bid);
      pg8::EpiProj E{(bf16*)(ws + WS_PROJ), p.in[I_BIN]}; pg8::gemm_phase<pg8::EpiProj, pg8::StaticOrder, true, true>(lds, gm, S, E); }
    grid.sync();
    for (int u = bid; u < 8 * NSC; u += G) m1_unit(p, u / NSC, u % NSC, lds);
    for (int u = bid; u < (M / 64) * 8; u += G) rg_unit(p, u >> 3, u & 7, 0, lds);
    grid.sync();
    m2_scan(p);
    for (int u = bid; u < 32; u += G) rg_carry_unit(p, u, lds);
    grid.sync();
    for (int u = bid; u < 8 * NSC; u += G) m3_unit(p, u / NSC, u % NSC, lds);
    for (int u = bid; u < (M / 64) * 8; u += G) rg_unit(p, u >> 3, u & 7, 1, lds);
    grid.sync();
    { pg8::Gemm gm{U, (const bf16*)(ws + WS_WOUT), M, D, D}; pg8::StaticOrder S; S.init(M, D, G, bid);
      pg8::EpiRes E{XB, XB, mod + 1 * 3 * D + 2 * D, NMOD, ALPHA, 1.0f}; pg8::gemm_phase<pg8::EpiRes, pg8::StaticOrder, true, true>(lds, gm, S, E); }
    grid.sync();
    row_pass(p, XB, XB, 1, 2, false);
    grid.sync();
    { pg8::Gemm gm{U, (const bf16*)(ws + WS_W13B), M, 2 * FF, D}; pg8::StaticOrder S; S.init(M, 2 * FF, G, bid);
      pg8::EpiSwiglu E{Hb, FF}; pg8::gemm_phase<pg8::EpiSwiglu, pg8::StaticOrder, true, true>(lds, gm, S, E); }
    grid.sync();
    { pg8::Gemm gm{Hb, (const bf16*)(ws + WS_W2B), M, D, FF}; pg8::StaticOrder S; S.init(M, D, G, bid);
      pg8::EpiRes E{XB, XB, mod + 2 * 3 * D + 2 * D, NMOD, ALPHA, 0.5f}; pg8::gemm_phase<pg8::EpiRes, pg8::StaticOrder, true, true>(lds, gm, S, E); }
    grid.sync();
    row_pass(p, XB, XB, 2, -1, false);
}

extern "C" void kernel_launch(void* const* d_in, const int* in_sizes, int n_in, void* d_out, int out_size, void* d_ws, size_t ws_size, hipStream_t stream) {
    static int grid = 0;
    if (grid == 0) {
        if (n_in != 21 || out_size != M * D || ws_size < WS_END) { fprintf(stderr, "kernel_launch: unexpected shapes (n_in %d, out %d, ws %zu < %zu)\n", n_in, out_size, ws_size, (size_t)WS_END); grid = -1; return; }
        int dev = 0, cus = 0, per_cu = 0;
        hipGetDevice(&dev); hipDeviceGetAttribute(&cus, hipDeviceAttributeMultiprocessorCount, dev);
        if (hipFuncSetAttribute((const void*)hybrid_fwd, hipFuncAttributeMaxDynamicSharedMemorySize, LDS_BYTES) != hipSuccess) { fprintf(stderr, "kernel_launch: hipFuncSetAttribute failed\n"); grid = -1; return; }
        if (hipOccupancyMaxActiveBlocksPerMultiprocessor(&per_cu, (const void*)hybrid_fwd, 512, LDS_BYTES) != hipSuccess || per_cu < 1) { fprintf(stderr, "kernel_launch: occupancy query gives %d\n", per_cu); per_cu = 1; }
        (void)hipGetLastError();
        grid = cus;
    }
    if (grid < 0) return;
    hipMemsetAsync((char*)d_ws + WS_MOD, 0, WS_ZERO_BYTES, stream);
    Params p{};
    for (int i = 0; i < 21; ++i) p.in[i] = (const float*)d_in[i];
    p.out = (float*)d_out; p.ws = (unsigned char*)d_ws;
    void* args[] = {&p};
    hipError_t e = hipLaunchCooperativeKernel((const void*)hybrid_fwd, dim3(grid), dim3(512), args, LDS_BYTES, stream);
    if (e != hipSuccess) fprintf(stderr, "cooperative launch failed: %s (grid %d)\n", hipGetErrorString(e), grid);
}
```

```cpp
#include <hip/hip_runtime.h>
#include <hip/hip_cooperative_groups.h>
#include <cstdio>
#include <cstdint>
namespace cg = cooperative_groups;
__device__ __forceinline__ int otid(int wv) { int t; asm volatile("v_mbcnt_lo_u32_b32 %0, -1, 0\n\tv_mbcnt_hi_u32_b32 %0, -1, %0" : "=v"(t)); return t + 64 * wv; }
__device__ __forceinline__ const float* kin(int i) { int o = __builtin_amdgcn_readfirstlane(i * 8); asm volatile("" : "+s"(o));
    typedef const float* cfp; return *(const __attribute__((address_space(4))) cfp*)((const __attribute__((address_space(4))) char*)__builtin_amdgcn_kernarg_segment_ptr() + o); }
#define UP8_CFG0 false
#define UP8_CFG1 true
#define DN8_CFG0 true
#define DN8_CFG1 true
namespace pg8 {
#define PG8_LAS __attribute__((address_space(3)))
typedef unsigned short bf16_t;
typedef short bf16x8 __attribute__((ext_vector_type(8)));
typedef float f32x4 __attribute__((ext_vector_type(4)));
typedef unsigned u32x4 __attribute__((ext_vector_type(4)));
constexpr int BM = 256, BK = 64, HALF = 128, HTB = HALF * BK * 2  , STAGE_BYTES = 8 * HTB, NXCD = 8, WGM = 4;

__host__ __device__ __forceinline__ int lds_byte(int r, int c) { const int st = (r >> 4) * 2 + (c >> 5), rr = r & 15, cc = c & 31, ob = rr * 64 + cc * 2; return st * 1024 + (ob ^ (((ob >> 9) & 1) << 5)); }
__host__ __device__ __forceinline__ void stage_rc(int b, int& R, int& C) { const int st = b / 1024, sb = b % 1024, swz = sb ^ (((sb >> 9) & 1) << 5); R = (st >> 1) * 16 + swz / 64; C = (st & 1) * 32 + (swz % 64) / 2; }
__host__ __device__ __forceinline__ int perm32(int rho) { const int n = rho >> 4, i = rho & 15; return 8 * (i >> 2) + 4 * n + (i & 3); }

struct Unit { int pm, pn; };
struct Gemm { const bf16_t* A; const bf16_t* Bt; int M, N, K, wv; };

struct StaticOrder {
    int nM, nN, nwg, G, c, wgm;
    __host__ __device__ void init(int M, int N, int G_, int c_, int wgm_ = WGM) { nM = M / BM; nN = N / BM; nwg = nM * nN; G = G_; c = c_; wgm = wgm_; }
    __host__ __device__ bool next(int i, Unit& u) const {
        const long L = (long)i * G + c; if (L >= nwg) return false;
        int wgid = (int)L; { const int q = nwg / NXCD, r = nwg % NXCD, xcd = wgid % NXCD, off = wgid / NXCD; wgid = (xcd < r ? xcd * (q + 1) : r * (q + 1) + (xcd - r) * q) + off; }
        const int nig = wgm * nN, gid = wgid / nig, fm = gid * wgm, gsz = (nM - fm) < wgm ? (nM - fm) : wgm;
        u.pm = fm + ((wgid % nig) % gsz); u.pn = (wgid % nig) / gsz; return true;
    }
    __device__ __forceinline__ void a_ready(const Unit&) const {}
    __device__ __forceinline__ void done(const Unit&) const {}
};
typedef int i32x8 __attribute__((ext_vector_type(8)));
__device__ __forceinline__ unsigned cvt_pk_bf16(float lo, float hi) { unsigned r; asm volatile("v_cvt_pk_bf16_f32 %0, %1, %2" : "=v"(r) : "v"(lo), "v"(hi)); return r; }
template <bool OUT8> struct EpiSwiglu {
    static constexpr bool PERM = true, AFTER_DRAIN = false;
    void* O; int ldc; float sc, hs;
    __device__ __forceinline__ void operator()(const f32x4 (&acc)[2][2][4][2], const Unit& u, int wr, int wc, int fr, int fq) const {
        const int row0 = u.pm * BM + wr * 64 + fr, col0 = u.pn * HALF + wc * 32 + 8 * fq;
        const float nsc = -1.4426950408889634f * sc, vs = sc * sc * (OUT8 ? hs : 1.0f);
#pragma unroll
        for (int ai = 0; ai < 2; ++ai)
#pragma unroll
            for (int m = 0; m < 4; ++m) {
                float h[8];
#pragma unroll
                for (int n = 0; n < 2; ++n) {
                    const f32x4 g4 = acc[ai][0][m][n], num = (g4 * acc[ai][1][m][n]) * vs, ea = g4 * nsc; f32x4 den;
#pragma unroll
                    for (int j = 0; j < 4; ++j) den[j] = __builtin_amdgcn_exp2f(ea[j]);
                    den = den + 1.0f;
#pragma unroll
                    for (int j = 0; j < 4; ++j) h[4 * n + j] = num[j] * __builtin_amdgcn_rcpf(den[j]); }
                const size_t off = (size_t)(row0 + ai * HALF + m * 16) * ldc + col0;
                if constexpr (OUT8) { unsigned w0 = 0u, w1 = 0u;
                    w0 = __builtin_amdgcn_cvt_pk_fp8_f32(h[0], h[1], w0, false); w0 = __builtin_amdgcn_cvt_pk_fp8_f32(h[2], h[3], w0, true);
                    w1 = __builtin_amdgcn_cvt_pk_fp8_f32(h[4], h[5], w1, false); w1 = __builtin_amdgcn_cvt_pk_fp8_f32(h[6], h[7], w1, true);
                    typedef unsigned u32x2 __attribute__((ext_vector_type(2))); *(u32x2*)((unsigned char*)O + off) = (u32x2){w0, w1};
                } else { u32x4 w; w.x = cvt_pk_bf16(h[0], h[1]); w.y = cvt_pk_bf16(h[2], h[3]); w.z = cvt_pk_bf16(h[4], h[5]); w.w = cvt_pk_bf16(h[6], h[7]);
                    *(u32x4*)((bf16_t*)O + off) = w; } }
    }
};
typedef _Float16 f16x4 __attribute__((ext_vector_type(4)));
template <bool LNRES> struct EpiRes {
    static constexpr bool PERM = false, AFTER_DRAIN = false;
    const void* res; bf16_t* out; const float* gate; const float* stat; float coef; int ln_idx;
    static constexpr int gate_bstride = 18432; static constexpr float alpha = 1.189207115002721f;
    __device__ __forceinline__ void operator()(const f32x4 (&acc)[2][2][4][2], const Unit& u, int wr, int wc, int fr, int fq) const {
        typedef float f32x2v __attribute__((ext_vector_type(2))); typedef unsigned u32x2 __attribute__((ext_vector_type(2)));
        const void* const res_ = res; bf16_t* const out_ = out; const float* const gate_ = gate; const float coef_ = coef; const float* const stat_ = stat; const int ln_ = ln_idx;
        const int row0 = u.pm * BM + wr * 64 + fr, col0 = u.pn * BM + wc * 32 + 4 * fq;
        const float* gp = gate_ + (size_t)(u.pm >> 5) * gate_bstride + col0;
#pragma unroll
        for (int bj = 0; bj < 2; ++bj)
#pragma unroll
            for (int n = 0; n < 2; ++n) {
                const int co = bj * HALF + n * 16;
                const f32x4 gv = *(const f32x4*)(gp + co) * coef_;
                f32x4 lg = {1.f, 1.f, 1.f, 1.f}, lb = {0.f, 0.f, 0.f, 0.f};
                if constexpr (LNRES) { lg = *(const f32x4*)(kin(19) + ln_ * 2048 + col0 + co); lb = *(const f32x4*)(kin(20) + ln_ * 2048 + col0 + co); }
#pragma unroll
                for (int ai = 0; ai < 2; ++ai)
#pragma unroll
                    for (int m = 0; m < 4; ++m) { const int row = row0 + ai * HALF + m * 16; const size_t off = (size_t)row * 2048 + col0 + co;
                        f32x4 r;
                        if constexpr (LNRES) { r = __builtin_convertvector(*(const f16x4*)((const bf16_t*)res_ + off), f32x4);
                            const f32x2v st = *(const f32x2v*)(stat_ + 2 * (size_t)row); r = (r - st.x) * st.y * lg + lb; }
                        else r = __builtin_nontemporal_load((const f32x4*)((const float*)res_ + off));
                        const f32x4 z = r * alpha + gv * acc[ai][bj][m][n];
                        *(f16x4*)(out_ + off) = __builtin_convertvector(z, f16x4); }
                if (bj == 0 && n == 1) __builtin_amdgcn_sched_barrier(0); }
    }
};
struct EpiProj {
    static constexpr bool PERM = true, AFTER_DRAIN = false;
    bf16_t* O; const float* bias;
    __device__ __forceinline__ void operator()(const f32x4 (&acc)[2][2][4][2], const Unit& u, int wr, int wc, int fr, int fq) const {
        const int row0 = u.pm * BM + wr * 64 + fr; const int colt = u.pn * BM; const int t = colt >> 10;
        bf16_t* base = O + (size_t)t * ((size_t)16384 * 1024);
        const int col0 = (colt & 1023) + wc * 32 + 8 * fq, bcol0 = colt + (colt >= 4096 ? 8 : 0) + wc * 32 + 8 * fq;
        f32x4 bv[2][2];
#pragma unroll
        for (int bj = 0; bj < 2; ++bj)
#pragma unroll
            for (int n = 0; n < 2; ++n) { const float* bp = bias + bcol0 + bj * HALF + 4 * n; bv[bj][n] = (f32x4){bp[0], bp[1], bp[2], bp[3]}; }
#pragma unroll
        for (int ai = 0; ai < 2; ++ai)
#pragma unroll
            for (int m = 0; m < 4; ++m) { bf16_t* rowp = base + (size_t)(row0 + ai * HALF + m * 16) * 1024 + col0;
#pragma unroll
                for (int bj = 0; bj < 2; ++bj) { const f32x4 v0 = acc[ai][bj][m][0] + bv[bj][0], v1 = acc[ai][bj][m][1] + bv[bj][1];
                    u32x4 w; w.x = cvt_pk_bf16(v0[0], v0[1]); w.y = cvt_pk_bf16(v0[2], v0[3]); w.z = cvt_pk_bf16(v1[0], v1[1]); w.w = cvt_pk_bf16(v1[2], v1[3]);
                    *(u32x4*)(rowp + bj * HALF) = w; } }
    }
};
template <class Epi, class Sched, bool ALIGN_EPI = false, bool SP2 = false, bool FP8 = false>
__device__ __forceinline__ void gemm_phase(PG8_LAS unsigned char* lds, const Gemm g, const Sched& S, const Epi& E) {
    const int tid = otid(g.wv), wid = __builtin_amdgcn_readfirstlane(tid >> 6), lane = tid & 63, wr = wid >> 2, wc = wid & 3, fr = lane & 15, fq = lane >> 4;
    const int K = g.K, nt = K / BK;
    unsigned voffA, voffB;
    { int R, C; stage_rc(tid * 16, R, C); const int Rb = Epi::PERM ? ((R & ~31) + perm32(R & 31)) : R;
        voffA = (unsigned)(R * K + C) * 2u; voffB = (unsigned)(Rb * K + C) * 2u; }
    const size_t istep = (size_t)64 * K * 2;
    const size_t kstep = (size_t)(BK * 2);
    const size_t hstep = (size_t)HALF * K * 2;
    const size_t tstep = 2 * hstep;
    const unsigned ldsw = (unsigned)wid * 1024u;
    const int aoff = lds_byte(wr * 64 + fr, fq * 8), boff = lds_byte(wc * 32 + fr, fq * 8);
#define PG8_SA(b, h) (((b) * 2 + (h)) * HTB)
#define PG8_SB(b, h) ((4 + (b) * 2 + (h)) * HTB)
#define PG8_STAGE(bufoff, gbase, voff) do { _Pragma("unroll") for (int _i = 0; _i < 2; ++_i) \
        __builtin_amdgcn_global_load_lds((const unsigned*)((const char*)(gbase) + (size_t)_i * istep + (voff)), (PG8_LAS unsigned*)(lds + (bufoff) + ldsw + _i * 8192), 16, 0, 0); } while (0)
#define PG8_LDA(dst, b, h) do { _Pragma("unroll") for (int m = 0; m < 4; ++m) _Pragma("unroll") for (int k = 0; k < 2; ++k) dst[m][k] = *(const PG8_LAS bf16x8*)(lds + PG8_SA(b, h) + aoff + m * 2048 + k * 1024); } while (0)
#define PG8_LDB(dst, b, h) do { _Pragma("unroll") for (int n = 0; n < 2; ++n) _Pragma("unroll") for (int k = 0; k < 2; ++k) dst[n][k] = *(const PG8_LAS bf16x8*)(lds + PG8_SB(b, h) + boff + n * 2048 + k * 1024); } while (0)
#define PG8_MMA(ai, bj, At, Bt) do { __builtin_amdgcn_s_setprio(1); _Pragma("unroll") for (int m = 0; m < 4; ++m) _Pragma("unroll") for (int n = 0; n < 2; ++n) { \
        if constexpr (FP8) { acc[ai][bj][m][n] = __builtin_amdgcn_mfma_scale_f32_16x16x128_f8f6f4(__builtin_bit_cast(i32x8, __builtin_shufflevector(Bt[n][0], Bt[n][1], 0, 1, 2, 3, 4, 5, 6, 7, 8, 9, 10, 11, 12, 13, 14, 15)), \
                __builtin_bit_cast(i32x8, __builtin_shufflevector(At[m][0], At[m][1], 0, 1, 2, 3, 4, 5, 6, 7, 8, 9, 10, 11, 12, 13, 14, 15)), acc[ai][bj][m][n], 0, 0, 0, 0x7F7F7F7F, 0, 0x7F7F7F7F); } \
        else { _Pragma("unroll") for (int k = 0; k < 2; ++k) acc[ai][bj][m][n] = __builtin_amdgcn_mfma_f32_16x16x32_bf16(Bt[n][k], At[m][k], acc[ai][bj][m][n], 0, 0, 0); } } \
        __builtin_amdgcn_s_setprio(0); } while (0)
#define PG8_WAIT_V(n) asm volatile("s_waitcnt vmcnt(" #n ")" ::: "memory")
#define PG8_WAIT_L(n) asm volatile("s_waitcnt lgkmcnt(" #n ")" ::: "memory")
#define PG8_BAR __builtin_amdgcn_s_barrier()
#define PG8_SCHED __builtin_amdgcn_sched_barrier(0)
    Unit cur, nxt; int ui = 0;
    if (!S.next(0, cur)) return;
    f32x4 acc[2][2][4][2];
#pragma unroll
    for (int a = 0; a < 2; ++a)
#pragma unroll
        for (int b = 0; b < 2; ++b)
#pragma unroll
            for (int m = 0; m < 4; ++m)
#pragma unroll
                for (int n = 0; n < 2; ++n) acc[a][b][m][n] = (f32x4){0.f, 0.f, 0.f, 0.f};
    bf16x8 At[4][2], B0[2][2], B1[2][2];
    const char* cA = (const char*)g.A + (size_t)cur.pm * tstep; const char* cB = (const char*)g.Bt + (size_t)cur.pn * tstep;
    S.a_ready(cur);
    if constexpr (SP2) {
        PG8_STAGE(PG8_SB(0, 0), cB, voffB); PG8_STAGE(PG8_SB(0, 1), cB + hstep, voffB); PG8_STAGE(PG8_SA(0, 0), cA, voffA); PG8_STAGE(PG8_SA(0, 1), cA + hstep, voffA);
        if (wr == 1) PG8_BAR;
        PG8_WAIT_V(2); PG8_BAR;
        PG8_STAGE(PG8_SB(1, 0), cB + kstep, voffB); PG8_STAGE(PG8_SA(1, 0), cA + kstep, voffA); PG8_STAGE(PG8_SB(1, 1), cB + hstep + kstep, voffB);
        PG8_WAIT_V(6); PG8_BAR;
    } else {
        PG8_STAGE(PG8_SB(0, 0), cB, voffB); PG8_STAGE(PG8_SA(0, 0), cA, voffA); PG8_STAGE(PG8_SB(0, 1), cB + hstep, voffB); PG8_STAGE(PG8_SA(0, 1), cA + hstep, voffA);
        if (wr == 1) PG8_BAR;
        PG8_WAIT_V(4); PG8_BAR;
        PG8_STAGE(PG8_SB(1, 0), cB + kstep, voffB); PG8_STAGE(PG8_SA(1, 0), cA + kstep, voffA); PG8_STAGE(PG8_SB(1, 1), cB + hstep + kstep, voffB);
        PG8_WAIT_V(6); PG8_BAR;
    }
    for (;;) {
        const bool has_next = S.next(ui + 1, nxt);
        const char* nA = has_next ? (const char*)g.A + (size_t)nxt.pm * tstep : cA; const char* nB = has_next ? (const char*)g.Bt + (size_t)nxt.pn * tstep : cB;
        for (int t = 0; t < nt; t += 2) {
            const bool last = (t == nt - 2);
            const char* a1 = cA + (size_t)(t + 1) * kstep;
            const char* a2 = last ? nA : cA + (size_t)(t + 2) * kstep; const char* b2 = last ? nB : cB + (size_t)(t + 2) * kstep;
            const char* a3 = a2 + kstep; const char* b3 = b2 + kstep;
            if (last && has_next) S.a_ready(nxt);
            if constexpr (SP2) {
            PG8_LDB(B0, 0, 0); PG8_LDB(B1, 0, 1); PG8_SCHED; PG8_LDA(At, 0, 0); PG8_STAGE(PG8_SA(1, 1), a1 + hstep, voffA);
            PG8_WAIT_V(8); PG8_WAIT_L(0); PG8_BAR; PG8_MMA(0, 0, At, B0); PG8_MMA(0, 1, At, B1); PG8_BAR; PG8_SCHED;
            PG8_LDA(At, 0, 1); PG8_STAGE(PG8_SB(0, 0), b2, voffB); PG8_STAGE(PG8_SB(0, 1), b2 + hstep, voffB); PG8_STAGE(PG8_SA(0, 0), a2, voffA);
            PG8_WAIT_V(8); PG8_WAIT_L(0); PG8_BAR; PG8_MMA(1, 0, At, B0); PG8_MMA(1, 1, At, B1); PG8_BAR; PG8_SCHED;
            PG8_LDB(B0, 1, 0); PG8_LDB(B1, 1, 1); PG8_SCHED; PG8_LDA(At, 1, 0); PG8_STAGE(PG8_SA(0, 1), a2 + hstep, voffA);
            PG8_WAIT_V(8); PG8_WAIT_L(0); PG8_BAR; PG8_MMA(0, 0, At, B0); PG8_MMA(0, 1, At, B1); PG8_BAR; PG8_SCHED;
            PG8_LDA(At, 1, 1); PG8_STAGE(PG8_SB(1, 0), b3, voffB); PG8_STAGE(PG8_SB(1, 1), b3 + hstep, voffB); PG8_STAGE(PG8_SA(1, 0), a3, voffA);
            PG8_WAIT_V(8); PG8_WAIT_L(0); PG8_BAR; PG8_MMA(1, 0, At, B0); PG8_MMA(1, 1, At, B1); PG8_BAR; PG8_SCHED;
            } else {
            PG8_LDB(B0, 0, 0); PG8_SCHED; PG8_LDA(At, 0, 0); PG8_STAGE(PG8_SA(1, 1), a1 + hstep, voffA);
            PG8_WAIT_L(8); PG8_BAR; PG8_WAIT_L(0); PG8_MMA(0, 0, At, B0); PG8_BAR; PG8_SCHED;
            PG8_LDB(B1, 0, 1); PG8_STAGE(PG8_SB(0, 0), b2, voffB);
            PG8_BAR; PG8_WAIT_L(0); PG8_MMA(0, 1, At, B1); PG8_BAR;
            PG8_LDA(At, 0, 1); PG8_STAGE(PG8_SA(0, 0), a2, voffA);
            PG8_BAR; PG8_WAIT_L(0); PG8_MMA(1, 0, At, B0); PG8_BAR; PG8_SCHED;
            PG8_STAGE(PG8_SB(0, 1), b2 + hstep, voffB);
            PG8_WAIT_V(6); PG8_BAR; PG8_MMA(1, 1, At, B1); PG8_BAR;
            PG8_LDB(B0, 1, 0); PG8_SCHED; PG8_LDA(At, 1, 0); PG8_STAGE(PG8_SA(0, 1), a2 + hstep, voffA);
            PG8_WAIT_L(8); PG8_BAR; PG8_WAIT_L(0); PG8_MMA(0, 0, At, B0); PG8_BAR; PG8_SCHED;
            PG8_LDB(B1, 1, 1); PG8_STAGE(PG8_SB(1, 0), b3, voffB);
            PG8_BAR; PG8_WAIT_L(0); PG8_MMA(0, 1, At, B1); PG8_BAR;
            PG8_LDA(At, 1, 1); PG8_STAGE(PG8_SA(1, 0), a3, voffA);
            PG8_BAR; PG8_WAIT_L(0); PG8_MMA(1, 0, At, B0); PG8_BAR; PG8_SCHED;
            PG8_STAGE(PG8_SB(1, 1), b3 + hstep, voffB);
            PG8_WAIT_V(6); PG8_BAR; PG8_MMA(1, 1, At, B1); PG8_BAR;
            }
        }
        if constexpr (ALIGN_EPI) { if (wr == 0) PG8_BAR; }
        if constexpr (!Epi::AFTER_DRAIN) { const int t2_ = otid(g.wv), fr_ = t2_ & 15, fq_ = (t2_ >> 4) & 3; E(acc, cur, wr, wc, fr_, fq_); S.done(cur); }
        if (!has_next) break;
#pragma unroll
        for (int a = 0; a < 2; ++a)
#pragma unroll
            for (int b = 0; b < 2; ++b)
#pragma unroll
                for (int m = 0; m < 4; ++m)
#pragma unroll
                    for (int n = 0; n < 2; ++n) acc[a][b][m][n] = (f32x4){0.f, 0.f, 0.f, 0.f};
        cur = nxt; cA = nA; cB = nB; ++ui;
        if constexpr (ALIGN_EPI) { if (wr == 1) PG8_BAR; }
    }
    PG8_WAIT_V(0);
    if constexpr (!ALIGN_EPI) { if (wr == 0) PG8_BAR; }
    PG8_BAR;
    if constexpr (Epi::AFTER_DRAIN) { E.fused(acc, cur, wr, wc, fr, fq, lds, wid, lane); S.done(cur); }
#undef PG8_SA
#undef PG8_SB
#undef PG8_STAGE
#undef PG8_LDA
#undef PG8_LDB
#undef PG8_MMA
#undef PG8_WAIT_V
#undef PG8_WAIT_L
#undef PG8_BAR
#undef PG8_SCHED
}
}

#define LAS __attribute__((address_space(3)))
typedef unsigned short bf16;
typedef unsigned v4u __attribute__((ext_vector_type(4)));
typedef unsigned v2u __attribute__((ext_vector_type(2)));
typedef float f32x4 __attribute__((ext_vector_type(4)));
typedef short bf16x8 __attribute__((ext_vector_type(8)));
typedef short s16x4 __attribute__((ext_vector_type(4)));

constexpr int NBATCH = 2, SEQ = 8192, M = NBATCH * SEQ, D = 2048, FF = 5632, DH = 256, NH = 4, DR = 1024;
constexpr int NMOD = 18432, INCOLS = 6152, NPROJ = 6144;
constexpr int SC = 256, NSC = SEQ / SC;
constexpr int CROWS = 272;
constexpr float ALPHA = 1.189207115002721f;
constexpr float LN_EPS = 1e-5f;
constexpr size_t MiB = (size_t)1 << 20;
constexpr size_t WS_MOD = 0, WS_BAR = 160 * 1024, WS_ZERO_BYTES = 256 * 1024;
constexpr size_t WS_WGT = 1 * MiB, WS_GATES = 2 * MiB, WS_MDEC = 3 * MiB, WS_QP = 3 * MiB + 256 * 1024, WS_STAT = 7 * MiB  , WS_RGP = 4 * MiB, WS_RGH = 5 * MiB, WS_RGC = 6 * MiB;
constexpr size_t WS_WAT = 8 * MiB, WS_WXT = 8 * MiB + 512 * 1024;
constexpr size_t WS_WOUT = 9 * MiB, WS_WIN = 17 * MiB, WS_W13A = 41 * MiB, WS_W13B = 85 * MiB, WS_W2A = 107 * MiB, WS_W2B = 118 * MiB;
constexpr size_t WS_U = 129 * MiB;
constexpr size_t WS_H = 193 * MiB;
constexpr size_t WS_PROJ = 193 * MiB;
constexpr size_t WS_DC = 385 * MiB;
constexpr size_t WS_CB = 453 * MiB;
constexpr int NKC = 28;
constexpr size_t WS_MODP = 487 * MiB;
constexpr size_t WS_XBH = 492 * MiB;
constexpr size_t WS_END = 556 * MiB;
constexpr int LDS_BYTES = 135168;

struct Params { const float* in[21]; float* out; unsigned char* ws; int wv, pad; };
enum { I_X = 0, I_C, I_WADA, I_BADA, I_F1W13, I_F1W2, I_WIN, I_BIN, I_MNG, I_CONVW, I_CONVB, I_WA, I_BA, I_WX, I_BX, I_LAM, I_WOUT, I_F2W13, I_F2W2, I_LNG, I_LNB };

#define LDS_BARRIER() do { asm volatile("s_waitcnt lgkmcnt(0)" ::: "memory"); __builtin_amdgcn_s_barrier(); asm volatile("" ::: "memory"); } while (0)
#define LDS_WAIT() asm volatile("s_waitcnt lgkmcnt(0)" ::: "memory")
__device__ __forceinline__ unsigned f2bf(float f) { unsigned u = __builtin_bit_cast(unsigned, f); return (u + 0x7fffu + ((u >> 16) & 1u)) >> 16; }
__device__ __forceinline__ unsigned pk2(float lo, float hi) { unsigned r; asm("v_cvt_pk_bf16_f32 %0, %1, %2" : "=v"(r) : "v"(lo), "v"(hi)); return r; }
__device__ __forceinline__ float bflo(unsigned w) { return __builtin_bit_cast(float, w << 16); }
__device__ __forceinline__ float bfhi(unsigned w) { return __builtin_bit_cast(float, w & 0xffff0000u); }
__device__ __forceinline__ float shx(float v, int m, int lane) { return __builtin_bit_cast(float, __builtin_amdgcn_ds_bpermute((lane ^ m) << 2, __builtin_bit_cast(int, v))); }
__device__ __forceinline__ float shup(float v, int d, int lane) { const int s = lane - d; return __builtin_bit_cast(float, __builtin_amdgcn_ds_bpermute((s < 0 ? lane : s) << 2, __builtin_bit_cast(int, v))); }
__device__ __forceinline__ float shfrom(float v, int src) { return __builtin_bit_cast(float, __builtin_amdgcn_ds_bpermute(src << 2, __builtin_bit_cast(int, v))); }
__device__ __forceinline__ float wave_sum(float v, int lane) {
#pragma unroll
    for (int o = 1; o < 64; o <<= 1) v += shx(v, o, lane);
    return v;
}
__device__ __forceinline__ float sigm(float x) { return __builtin_amdgcn_rcpf(1.0f + __builtin_amdgcn_exp2f(-1.4426950408889634f * x)); }
__device__ __forceinline__ float logsigm(float x) { return x < 0.f ? x - log1pf(__expf(x)) : -log1pf(__expf(-x)); }
__device__ __forceinline__ s16x4 tr_read(LAS unsigned char* p) {
    typedef short v4i16_t __attribute__((ext_vector_type(4)));
    return __builtin_bit_cast(s16x4, __builtin_amdgcn_ds_read_tr16_b64_v4i16((LAS v4i16_t*)p));
}
__device__ __forceinline__ bf16x8 cat8(s16x4 lo, s16x4 hi) { return __builtin_shufflevector(lo, hi, 0, 1, 2, 3, 4, 5, 6, 7); }
__device__ __forceinline__ unsigned pk4_fp8(float a, float b, float c, float d) { unsigned w = 0u;
    a = __builtin_amdgcn_fmed3f(a, -448.0f, 448.0f); b = __builtin_amdgcn_fmed3f(b, -448.0f, 448.0f); c = __builtin_amdgcn_fmed3f(c, -448.0f, 448.0f); d = __builtin_amdgcn_fmed3f(d, -448.0f, 448.0f);
    w = __builtin_amdgcn_cvt_pk_fp8_f32(a, b, w, false); w = __builtin_amdgcn_cvt_pk_fp8_f32(c, d, w, true); return w; }
constexpr float FP8_ASCALE = 4.0f, FP8_WSCALE = 64.0f;
constexpr float FP8_HSCALE = 2.0f, FP8_W2SCALE = 128.0f;
constexpr bool UP8_0 = UP8_CFG0, UP8_1 = UP8_CFG1, DN8_0 = DN8_CFG0, DN8_1 = DN8_CFG1;
static_assert(!UP8_0 && UP8_1 && DN8_0 && DN8_1, "the workspace map sizes the weight / H buffers for this fp8 configuration");
#define MFMA16(a, b, c) __builtin_amdgcn_mfma_f32_16x16x32_bf16((a), (b), (c), 0, 0, 0)

#define XB_TMO      128
#define XB_XCNT(j)  (256  + 64 * (j))
#define XB_XSUB(j)  (1280 + 64 * (j))
#define XB_XGEN(j)  (2304 + 64 * (j))
#define XB_TOP      3328
#define XB_TOPGEN   3392
#define XCD_BAR_WORDS 3456
#define XB_SPIN_CAP (1u << 18)

__device__ __forceinline__ unsigned xb_ld(unsigned* p)              { return __hip_atomic_load(p, __ATOMIC_RELAXED, __HIP_MEMORY_SCOPE_AGENT); }
__device__ __forceinline__ unsigned xb_add(unsigned* p, unsigned v) { return __hip_atomic_fetch_add(p, v, __ATOMIC_RELAXED, __HIP_MEMORY_SCOPE_AGENT); }
__device__ __forceinline__ unsigned xb_xcc_id() { return (unsigned)__builtin_amdgcn_s_getreg((3 << 11) | 20) & 0xFu; }
#define XB_SPIN(cond, bar) do { unsigned _sp = 0; while (cond) { __builtin_amdgcn_s_sleep(1); \
    if ((++_sp & 255u) == 0u) { if (xb_ld(&(bar)[XB_TMO])) break; if (_sp > XB_SPIN_CAP) { atomicAdd(&(bar)[XB_TMO], 1u); break; } } } } while (0)

struct XcdBarrier {
    unsigned* bar; unsigned x; int wv;
    volatile LAS unsigned* st;
};

__device__ __forceinline__ XcdBarrier xcd_barrier_post(unsigned* bar, volatile LAS unsigned* st, int wv) {
    XcdBarrier b; b.bar = bar; b.x = xb_xcc_id(); b.st = st; b.wv = wv;
    if (otid(wv) == 0) (void)xb_add(&bar[XB_XCNT(b.x)], 1u);
    return b;
}
__device__ __forceinline__ void xcd_barrier_complete(unsigned* bar, unsigned x, unsigned& nloc, unsigned& nx) {
    const unsigned G = gridDim.x * gridDim.y * gridDim.z;
    unsigned sum, cnt, mine, sp = 0u;
    for (;;) {
        sum = 0u; cnt = 0u; mine = 0u;
#pragma unroll
        for (unsigned j = 0; j < 16; ++j) { const unsigned c = xb_ld(&bar[XB_XCNT(j)]); sum += c; cnt += (c > 0u) ? 1u : 0u; mine = (j == x) ? c : mine; }
        if (sum == G) break;
        __builtin_amdgcn_s_sleep(1);
        if ((++sp & 255u) == 0u) { if (xb_ld(&bar[XB_TMO])) break; if (sp > XB_SPIN_CAP) { atomicAdd(&bar[XB_TMO], 1u); break; } }
    }
    nloc = mine > 0u ? mine : 1u; nx = cnt > 0u ? cnt : 1u;
}

__device__ __forceinline__ void xcd_barrier(const XcdBarrier& b) {
    asm volatile("s_waitcnt vmcnt(0)" ::: "memory");
    __syncthreads();
    if (otid(b.wv) == 0) {
        unsigned* bar = b.bar;
        __builtin_amdgcn_s_waitcnt(0);
        unsigned nloc = b.st[0], nx = b.st[1];
        if (nloc == 0u) { xcd_barrier_complete(bar, b.x, nloc, nx); b.st[0] = nloc; b.st[1] = nx; }
        const unsigned old = xb_add(&bar[XB_XSUB(b.x)], 1u);
        const unsigned gen = old / nloc;
        if (old + 1u == (gen + 1u) * nloc) {
            __builtin_amdgcn_fence(__ATOMIC_RELEASE, "agent");
            asm volatile("s_waitcnt vmcnt(0)" ::: "memory");
            const unsigned og = xb_add(&bar[XB_TOP], 1u);
            const unsigned tg = og / nx;
            if (og + 1u == (tg + 1u) * nx) xb_add(&bar[XB_TOPGEN], 1u);
            else XB_SPIN(xb_ld(&bar[XB_TOPGEN]) == tg, bar);
            __builtin_amdgcn_fence(__ATOMIC_ACQUIRE, "agent");
            xb_add(&bar[XB_XGEN(b.x)], 1u);
            asm volatile("s_waitcnt vmcnt(0)" ::: "memory");
        } else {
            XB_SPIN(xb_ld(&bar[XB_XGEN(b.x)]) == gen, bar);
            __builtin_amdgcn_fence(__ATOMIC_ACQUIRE, "agent");
            asm volatile("s_waitcnt vmcnt(0)" ::: "memory");
        }
    }
    __syncthreads();
}

__device__ __forceinline__ void tr_item(const float* __restrict__ W, int ldw, int K, int src_col, bf16* __restrict__ WT, int dst_row, int k0, LAS float* scr, int lane) {
#pragma unroll 8
    for (int i = 0; i < 32; ++i) { const int kk = 2 * i + (lane >> 5); scr[kk * 33 + (lane & 31)] = __builtin_nontemporal_load(W + (size_t)(k0 + kk) * ldw + src_col + (lane & 31));     }
    LDS_WAIT();
    const int c = lane & 7;
#pragma unroll
    for (int j = 0; j < 4; ++j) { const int n = (lane >> 3) + 8 * j; const LAS float* s = scr + (8 * c) * 33 + n;
        v4u o; o.x = pk2(s[0 * 33], s[1 * 33]); o.y = pk2(s[2 * 33], s[3 * 33]); o.z = pk2(s[4 * 33], s[5 * 33]); o.w = pk2(s[6 * 33], s[7 * 33]);
        *(v4u*)(WT + (size_t)(dst_row + n) * K + k0 + 8 * c) = o; }
    LDS_WAIT();
}
__device__ __forceinline__ void tr_item8(const float* __restrict__ W, int ldw, int K, int src_col, unsigned char* __restrict__ WT, int dst_row, int k0, LAS float* scr, int lane, float wsc) {
#pragma unroll 8
    for (int i = 0; i < 32; ++i) { const int kk = 2 * i + (lane >> 5); scr[kk * 33 + (lane & 31)] = __builtin_nontemporal_load(W + (size_t)(k0 + kk) * ldw + src_col + (lane & 31));     }
    LDS_WAIT();
    const int c = lane & 7;
#pragma unroll
    for (int j = 0; j < 4; ++j) { const int n = (lane >> 3) + 8 * j; const LAS float* s = scr + (8 * c) * 33 + n;
        v2u o; o.x = pk4_fp8(s[0 * 33] * wsc, s[1 * 33] * wsc, s[2 * 33] * wsc, s[3 * 33] * wsc); o.y = pk4_fp8(s[4 * 33] * wsc, s[5 * 33] * wsc, s[6 * 33] * wsc, s[7 * 33] * wsc);
        *(v2u*)(WT + (size_t)(dst_row + n) * K + k0 + 8 * c) = o; }
    LDS_WAIT();
}
__device__ __forceinline__ void p0_prologue(const Params& p, LAS unsigned char* lds) {
    const int tid = otid(p.wv), lane = tid & 63, wave = tid >> 6;
    unsigned char* ws = p.ws;
    LAS float* scr = (LAS float*)(lds + wave * 16384);
    const int gw = blockIdx.x * 8 + wave, NGW = gridDim.x * 8;
    constexpr int I_13 = 32 * 352, I_2 = 88 * 64, I_IN = 32 * 192, I_OUT = 32 * 64, I_RG = 64;
    constexpr int NITEMS = 2 * I_13 + 2 * I_2 + I_IN + I_OUT + 2 * I_RG;
    for (int it = gw; it < NITEMS; it += NGW) {
        int r = it;
        if (r < 2 * I_13) { const int which = r >= I_13; r -= which * I_13; const int kb = r / 352, nb = r % 352, n0 = 32 * nb, pt = n0 >> 8, rr = n0 & 255;
            const int sc = rr < 128 ? 128 * pt + rr : FF + 128 * pt + (rr - 128);
            if (which ? UP8_1 : UP8_0) tr_item8(kin(which ? I_F2W13 : I_F1W13), 2 * FF, D, sc, ws + (which ? WS_W13B : WS_W13A), n0, 64 * kb, scr, lane, FP8_WSCALE);
            else tr_item(kin(which ? I_F2W13 : I_F1W13), 2 * FF, D, sc, (bf16*)(ws + (which ? WS_W13B : WS_W13A)), n0, 64 * kb, scr, lane);
            continue; }
        r -= 2 * I_13;
        if (r < 2 * I_2) { const int which = r >= I_2; r -= which * I_2; const int kb = r >> 6, nb = r & 63;
            if (which ? DN8_1 : DN8_0) tr_item8(kin(which ? I_F2W2 : I_F1W2), D, FF, 32 * nb, ws + (which ? WS_W2B : WS_W2A), 32 * nb, 64 * kb, scr, lane, FP8_W2SCALE);
            else tr_item(kin(which ? I_F2W2 : I_F1W2), D, FF, 32 * nb, (bf16*)(ws + (which ? WS_W2B : WS_W2A)), 32 * nb, 64 * kb, scr, lane);
            continue; }
        r -= 2 * I_2;
        if (r < I_IN) { const int kb = r / 192, nb = r % 192, n0 = 32 * nb;
            tr_item(kin(I_WIN), INCOLS, D, n0 < 4096 ? n0 : n0 + 8, (bf16*)(ws + WS_WIN), n0, 64 * kb, scr, lane); continue; }
        r -= I_IN;
        if (r < I_OUT) { const int kb = r >> 6, nb = r & 63;
            tr_item(kin(I_WOUT), D, D, 32 * nb, (bf16*)(ws + WS_WOUT), 32 * nb, 64 * kb, scr, lane); continue; }
        r -= I_OUT;
        { const int which = r >= I_RG; r -= which * I_RG; const int blk = r >> 3, l = r & 7, kb = l >> 2, nb = l & 3;
            tr_item(kin(which ? I_WX : I_WA) + blk * 16384, 128, 128, 32 * nb, (bf16*)(ws + (which ? WS_WXT : WS_WAT)) + blk * 16384, 32 * nb, 64 * kb, scr, lane); }
    }
    __syncthreads();
    LAS float* sc = (LAS float*)lds;
    for (int i = tid; i < NBATCH * D; i += 512) { const float cv = kin(I_C)[i]; sc[i] = cv / (1.0f + __expf(-cv)); }
    __syncthreads();
    const int gid = blockIdx.x * 512 + tid;
    for (int it = gid; it < NKC * (NMOD / 4); it += gridDim.x * 512) {
        const int cgp = it % (NMOD / 4), kc = it / (NMOD / 4);
        const int k0 = 73 * kc + (kc < 4 ? kc : 4), klen = 73 + (kc < 4 ? 1 : 0);
        const f32x4* wp = (const f32x4*)(kin(I_WADA) + (size_t)k0 * NMOD) + cgp;
        f32x4 a0 = {0.f, 0.f, 0.f, 0.f}, a1 = {0.f, 0.f, 0.f, 0.f};
#pragma unroll 8
        for (int k = 0; k < klen; ++k) { const f32x4 w = __builtin_nontemporal_load(wp + (size_t)k * (NMOD / 4)); a0 += w * sc[k0 + k]; a1 += w * sc[D + k0 + k]; }
        if (kc == 0) { const f32x4 b4 = ((const f32x4*)kin(I_BADA))[cgp]; a0 += b4; a1 += b4; }
        f32x4* mp = (f32x4*)(ws + WS_MODP) + (size_t)kc * (2 * NMOD / 4) + cgp; mp[0] = a0; mp[NMOD / 4] = a1;
    }
    for (int it = gid; it < 8 * D; it += gridDim.x * 512) { const int g = it >> 11, k = it & 2047; ((float*)(ws + WS_WGT))[it] = kin(I_WIN)[(size_t)k * INCOLS + 4096 + g]; }
    __syncthreads();
}

constexpr int L_RP_G = 0, L_RP_B = 8192, L_RP_SC = 16384, L_RP_SH = 24576, L_RP_W = 32768, L_RP_GT = 98304;
__device__ __forceinline__ void row_pass(const Params& p, const void* src, bool src16  , float* dstx, int ln_idx  , int mod_idx  , bool do_gates, bool fp8out, bool from_partials, bool write_x, LAS unsigned char* lds) {
    const int tid = otid(p.wv), lane = tid & 63, wave = tid >> 6;
    const float* mod = (const float*)(p.ws + WS_MOD);
    bf16* U = (bf16*)(p.ws + WS_U);
    const int r0 = (int)(((long)blockIdx.x * M) / gridDim.x), r1 = (int)(((long)(blockIdx.x + 1) * M) / gridDim.x);
    LAS f32x4* Lg = (LAS f32x4*)(lds + L_RP_G); LAS f32x4* Lb = (LAS f32x4*)(lds + L_RP_B); LAS f32x4* Lsc = (LAS f32x4*)(lds + L_RP_SC); LAS f32x4* Lsh = (LAS f32x4*)(lds + L_RP_SH);
    LAS f32x4* Lw = (LAS f32x4*)(lds + L_RP_W);
    if (from_partials) {
        float* modw = (float*)(p.ws + WS_MOD); const float* pp = (const float*)(p.ws + WS_MODP);
        for (int i = blockIdx.x * 512 + tid; i < 2 * NMOD; i += gridDim.x * 512) { float s = 0.f;
#pragma unroll 4
            for (int kc = 0; kc < NKC; ++kc) s += pp[(size_t)kc * (2 * NMOD) + i];
            modw[i] = s; }
    }
    for (int b = 0; b < NBATCH; ++b) {
        const int s0 = r0 > b * SEQ ? r0 : b * SEQ, s1 = r1 < (b + 1) * SEQ ? r1 : (b + 1) * SEQ;
        if (s0 >= s1) continue;
        __syncthreads();
        if (ln_idx >= 0) { Lg[tid] = ((const f32x4*)(kin(I_LNG) + ln_idx * D))[tid]; Lb[tid] = ((const f32x4*)(kin(I_LNB) + ln_idx * D))[tid]; }
        if (mod_idx >= 0) {
            if (from_partials) { const f32x4* pp = (const f32x4*)(p.ws + WS_MODP) + ((size_t)b * NMOD + mod_idx * 3 * D) / 4 + tid; f32x4 sh = {0.f, 0.f, 0.f, 0.f}, sc = {0.f, 0.f, 0.f, 0.f};
#pragma unroll 4
                for (int kc = 0; kc < NKC; ++kc) { sh += pp[(size_t)kc * (2 * NMOD / 4)]; sc += pp[(size_t)kc * (2 * NMOD / 4) + D / 4]; }
                Lsh[tid] = sh; Lsc[tid] = sc + 1.0f;
            } else { const f32x4* mp = (const f32x4*)(mod + (size_t)b * NMOD + mod_idx * 3 * D); Lsh[tid] = mp[tid]; Lsc[tid] = mp[D / 4 + tid] + 1.0f; } }
        if (do_gates) { const f32x4* wg = (const f32x4*)(p.ws + WS_WGT);
#pragma unroll
            for (int g = 0; g < 8; ++g) Lw[g * 512 + tid] = wg[g * 512 + tid]; }
        __syncthreads();
        int m = s0 + wave;
        typedef _Float16 f16x4 __attribute__((ext_vector_type(4)));
        f32x4 nx[8]; f16x4 nh[8];
        const bool last_use = (mod_idx < 0);
#define RP_LOAD(row_) do { if (src16) { const f16x4* xr_ = (const f16x4*)((const bf16*)src + (size_t)(row_) * D) + lane; \
            if (last_use) { _Pragma("unroll") for (int j = 0; j < 8; ++j) nh[j] = __builtin_nontemporal_load(xr_ + 64 * j); } \
            else { _Pragma("unroll") for (int j = 0; j < 8; ++j) nh[j] = xr_[64 * j]; } } \
        else { const f32x4* xr_ = (const f32x4*)((const float*)src + (size_t)(row_) * D) + lane; _Pragma("unroll") for (int j = 0; j < 8; ++j) nx[j] = xr_[64 * j]; } } while (0)
        if (m < s1) RP_LOAD(m);
        for (; m < s1; m += 8) {
            f32x4 v[8]; f32x4 s4 = {0.f, 0.f, 0.f, 0.f};
#pragma unroll
            for (int j = 0; j < 8; ++j) { v[j] = src16 ? __builtin_convertvector(nh[j], f32x4) : nx[j]; s4 += v[j]; }
            if (m + 8 < s1) RP_LOAD(m + 8);
            float mean = wave_sum((s4.x + s4.y) + (s4.z + s4.w), lane) * (1.f / D); f32x4 q4 = {0.f, 0.f, 0.f, 0.f};
#pragma unroll
            for (int j = 0; j < 8; ++j) { v[j] = v[j] - mean; q4 += v[j] * v[j]; }
            float rstd = 1.0f / sqrtf(wave_sum((q4.x + q4.y) + (q4.z + q4.w), lane) * (1.f / D) + LN_EPS);
            if (ln_idx >= 0) {
                f32x4* xo = (f32x4*)(dstx + (size_t)m * D) + lane; s4 = (f32x4){0.f, 0.f, 0.f, 0.f};
#pragma unroll
                for (int j = 0; j < 8; ++j) { v[j] = (v[j] * rstd) * Lg[lane + 64 * j] + Lb[lane + 64 * j]; if (write_x) { if (last_use) __builtin_nontemporal_store(v[j], xo + 64 * j); else xo[64 * j] = v[j]; } s4 += v[j]; }
                if (!write_x && lane == 0) { float* st = (float*)(p.ws + WS_STAT) + 2 * (size_t)m; st[0] = mean; st[1] = rstd; }
                if (mod_idx < 0) continue;
                mean = wave_sum((s4.x + s4.y) + (s4.z + s4.w), lane) * (1.f / D); q4 = (f32x4){0.f, 0.f, 0.f, 0.f};
#pragma unroll
                for (int j = 0; j < 8; ++j) { v[j] = v[j] - mean; q4 += v[j] * v[j]; }
                rstd = 1.0f / sqrtf(wave_sum((q4.x + q4.y) + (q4.z + q4.w), lane) * (1.f / D) + LN_EPS);
            }
            if (fp8out) { unsigned* uo8 = (unsigned*)((unsigned char*)U + (size_t)m * D) + lane;
                const float rs = rstd * FP8_ASCALE;
#pragma unroll
                for (int j = 0; j < 8; ++j) { v[j] = (v[j] * rs) * Lsc[lane + 64 * j] + Lsh[lane + 64 * j] * FP8_ASCALE; uo8[64 * j] = pk4_fp8(v[j].x, v[j].y, v[j].z, v[j].w); }
            } else { v2u* uo = (v2u*)(U + (size_t)m * D) + lane;
#pragma unroll
                for (int j = 0; j < 8; ++j) { v[j] = (v[j] * rstd) * Lsc[lane + 64 * j] + Lsh[lane + 64 * j]; v2u w; w.x = pk2(v[j].x, v[j].y); w.y = pk2(v[j].z, v[j].w); uo[64 * j] = w; } }
            if (do_gates) {
                float d[8];
#pragma unroll
                for (int g = 0; g < 8; ++g) { f32x4 d4 = {0.f, 0.f, 0.f, 0.f};
#pragma unroll
                    for (int j = 0; j < 8; ++j) d4 += v[j] * Lw[g * 512 + lane + 64 * j];
                    d[g] = (d4.x + d4.y) + (d4.z + d4.w);
                    asm volatile("" ::: "memory"); }
                float e4[4], e2[2], e1;
                const bool h32 = lane & 32, h16 = lane & 16, h8 = lane & 8;
#pragma unroll
                for (int k = 0; k < 4; ++k) { const float keep = h32 ? d[k + 4] : d[k], send = h32 ? d[k] : d[k + 4]; e4[k] = keep + shx(send, 32, lane); }
#pragma unroll
                for (int k = 0; k < 2; ++k) { const float keep = h16 ? e4[k + 2] : e4[k], send = h16 ? e4[k] : e4[k + 2]; e2[k] = keep + shx(send, 16, lane); }
                { const float keep = h8 ? e2[1] : e2[0], send = h8 ? e2[0] : e2[1]; e1 = keep + shx(send, 8, lane); }
                e1 += shx(e1, 4, lane); e1 += shx(e1, 2, lane); e1 += shx(e1, 1, lane);
                if ((lane & 7) == 0) { const int g = (lane >> 3); const float gv = e1 + kin(I_BIN)[4096 + g]; ((float*)(p.ws + WS_GATES))[(size_t)m * 8 + g] = gv; ((LAS float*)(lds + L_RP_GT))[((m - s0) & 63) * 8 + g] = gv; }
            }
        }
        if (do_gates) {
            __syncthreads();
            if (tid < NH) { const LAS float* gt = (const LAS float*)(lds + L_RP_GT); float A = 0.f, B = -__builtin_inff();
                for (int t = 0; t < 64; ++t) { const float li = gt[t * 8 + tid], lf = logsigm(gt[t * 8 + 4 + tid]); B = fmaxf(B + lf, li); A += lf; }
                float* qp = (float*)(p.ws + WS_QP) + ((size_t)(s0 >> 6) * NH + tid) * 2; qp[0] = A; qp[1] = B; }
        }
    }
    __syncthreads();
}
constexpr int KV_BUF = 34816;
constexpr int KT_PITCH = 528, VT_PITCH = 560, KV_VOFF = 16896;
constexpr int CT_BUF = 50688;
constexpr int L_GB = 104448, L_GLI = L_GB + 1024, L_GM = L_GB + 2048, L_GW = L_GB + 3072, L_MISC = L_GB + 4096;

__device__ __forceinline__ void mlstm_gates(const float* __restrict__ gates, const float* __restrict__ qp, int b, int h, int j, LAS unsigned char* lds, int wv) {
    const int tid = otid(wv), lane = tid & 63, wave = tid >> 6;
    LAS float* GB = (LAS float*)(lds + L_GB); LAS float* GLI = (LAS float*)(lds + L_GLI); LAS float* GM = (LAS float*)(lds + L_GM); LAS float* MISC = (LAS float*)(lds + L_MISC);
    const float NEG = -__builtin_inff();
    if (wave == 0) {
        float A = 0.f, B = NEG;
#pragma unroll
        for (int i = 0; i < 2; ++i) { const int qi = 2 * lane + i; if (qi < 4 * j) { const float a = qp[((size_t)(b * 128 + qi) * NH + h) * 2], bb = qp[((size_t)(b * 128 + qi) * NH + h) * 2 + 1]; B = fmaxf(B + a, bb); A += a; } }
#pragma unroll
        for (int o = 1; o < 64; o <<= 1) { const float Ap = shup(A, o, lane), Bp = shup(B, o, lane); if (lane >= o) { B = fmaxf(Bp + A, B); A = Ap + A; } }
        const float mend = fmaxf(A, B);
        float ms = shfrom(mend, (2 * j - 1) & 63); if (j == 0) ms = 0.f;
        const float* gp = gates + ((size_t)b * SEQ + SC * j + 4 * lane) * 8;
        float li[4], lf[4], cs[4];
#pragma unroll
        for (int i = 0; i < 4; ++i) { li[i] = gp[i * 8 + h]; lf[i] = logsigm(gp[i * 8 + 4 + h]); }
        cs[0] = lf[0]; cs[1] = cs[0] + lf[1]; cs[2] = cs[1] + lf[2]; cs[3] = cs[2] + lf[3];
        float incl = cs[3];
#pragma unroll
        for (int o = 1; o < 64; o <<= 1) { const float t = shup(incl, o, lane); if (lane >= o) incl += t; }
        const float excl = incl - cs[3];
        float LA = cs[3], LB = NEG;
#pragma unroll
        for (int i = 0; i < 4; ++i) LB = fmaxf(LB + lf[i], li[i]);
#pragma unroll
        for (int o = 1; o < 64; o <<= 1) { const float Ap = shup(LA, o, lane), Bp = shup(LB, o, lane); if (lane >= o) { LB = fmaxf(Bp + LA, LB); LA = Ap + LA; } }
        const float Ae = shup(LA, 1, lane), Be = shup(LB, 1, lane);
        float mp = (lane == 0) ? ms : fmaxf(ms + Ae, Be);
#pragma unroll
        for (int i = 0; i < 4; ++i) { mp = fmaxf(mp + lf[i], li[i]); GB[4 * lane + i] = excl + cs[i]; GLI[4 * lane + i] = li[i]; GM[4 * lane + i] = mp; }
        if (lane == 0) MISC[0] = ms;
    }
    LDS_BARRIER();
}
#define KV_LOAD(blk) do { int t_ = tid; asm volatile("" : "+v"(t_)); _Pragma("unroll") for (int i_ = 0; i_ < 2; ++i_) { const int c_ = t_ + 512 * i_, r_ = c_ >> 5, ch_ = c_ & 31; \
        rk[i_] = *(const v4u*)(Kp + (size_t)(32 * (blk) + r_) * DR + 8 * ch_); rv[i_] = *(const v4u*)(Vp + (size_t)(32 * (blk) + r_) * DR + 8 * ch_); } } while (0)
#define KV_STORE(buf) do { int t_ = tid; asm volatile("" : "+v"(t_)); _Pragma("unroll") for (int i_ = 0; i_ < 2; ++i_) { const int c_ = t_ + 512 * i_, r_ = c_ >> 5, ch_ = c_ & 31; \
        *(LAS v4u*)(lds + (buf) * KV_BUF + r_ * KT_PITCH + 16 * ch_) = rk[i_]; *(LAS v4u*)(lds + (buf) * KV_BUF + KV_VOFF + r_ * VT_PITCH + 16 * ch_) = rv[i_]; } } while (0)
__device__ __forceinline__ void preset_ones_col(LAS unsigned char* lds, int tid) {
    if (tid < 128) { const int bf = tid >> 6, r = (tid >> 1) & 31, hf = tid & 1; v4u z = {0u, 0u, 0u, 0u}; if (!hf) z.x = 0x3F80u; *(LAS v4u*)(lds + bf * KV_BUF + KV_VOFF + r * VT_PITCH + 512 + 16 * hf) = z; }
}
__device__ __forceinline__ bf16x8 scale8(bf16x8 x, f32x4 wl, f32x4 wh) {
    const v4u u = __builtin_bit_cast(v4u, x); v4u o;
    o.x = pk2(bflo(u.x) * wl.x, bfhi(u.x) * wl.y); o.y = pk2(bflo(u.y) * wl.z, bfhi(u.y) * wl.w); o.z = pk2(bflo(u.z) * wh.x, bfhi(u.z) * wh.y); o.w = pk2(bflo(u.w) * wh.z, bfhi(u.w) * wh.w);
    return __builtin_bit_cast(bf16x8, o);
}
__device__ __forceinline__ void m1_unit(const Params& p, int bh, int j, LAS unsigned char* lds) {
    const int tid = otid(p.wv), lane = tid & 63, wave = tid >> 6, b = bh >> 2, h = bh & 3;
    LAS float* GB = (LAS float*)(lds + L_GB); LAS float* GLI = (LAS float*)(lds + L_GLI); LAS float* GM = (LAS float*)(lds + L_GM); LAS float* GW = (LAS float*)(lds + L_GW);
    LAS float* MISC = (LAS float*)(lds + L_MISC);
    const bf16* Kp = (const bf16*)(p.ws + WS_PROJ) + (size_t)1 * M * DR + ((size_t)b * SEQ + SC * j) * DR + h * DH;
    const bf16* Vp = (const bf16*)(p.ws + WS_PROJ) + (size_t)2 * M * DR + ((size_t)b * SEQ + SC * j) * DR + h * DH;
    v4u rk[2], rv[2];
    KV_LOAD(0);
    mlstm_gates((const float*)(p.ws + WS_GATES), (const float*)(p.ws + WS_QP), b, h, j, lds, p.wv);
    const float b_last = GB[SC - 1], m_end = GM[SC - 1], m_start = MISC[0];
    if (tid < SC) GW[tid] = __expf(b_last - GB[tid] + GLI[tid] - m_end) * 0.0625f;
    if (tid == 0) ((float*)(p.ws + WS_MDEC))[bh * NSC + j] = __expf(b_last + m_start - m_end);
    preset_ones_col(lds, tid);
    KV_STORE(0); KV_LOAD(1);
    LDS_BARRIER();
    f32x4 acc[17][2];
#pragma unroll
    for (int mt = 0; mt < 17; ++mt) { acc[mt][0] = (f32x4){0.f, 0.f, 0.f, 0.f}; acc[mt][1] = (f32x4){0.f, 0.f, 0.f, 0.f}; }
#pragma unroll 1
    for (int sb = 0; sb < 8; ++sb) {
        int g = lane >> 4, q = (lane & 15) >> 2, pp = lane & 3; asm volatile("" : "+v"(g), "+v"(q), "+v"(pp));
        LAS unsigned char* buf = lds + (sb & 1) * KV_BUF;
        {
            const int rowoff = 8 * g + q;
            LAS unsigned char* kb = buf + rowoff * KT_PITCH + (32 * wave + 4 * pp) * 2;
            const f32x4 wl = *(const LAS f32x4*)(GW + 32 * sb + 8 * g), wh = *(const LAS f32x4*)(GW + 32 * sb + 8 * g + 4);
            const bf16x8 b0 = scale8(cat8(tr_read(kb), tr_read(kb + 4 * KT_PITCH)), wl, wh), b1 = scale8(cat8(tr_read(kb + 32), tr_read(kb + 32 + 4 * KT_PITCH)), wl, wh);
            LAS unsigned char* vb = buf + KV_VOFF + rowoff * VT_PITCH + (4 * pp) * 2;
#pragma unroll
            for (int mt = 0; mt < 17; ++mt) { const bf16x8 a = cat8(tr_read(vb + 32 * mt), tr_read(vb + 32 * mt + 4 * VT_PITCH));
                acc[mt][0] = MFMA16(a, b0, acc[mt][0]); acc[mt][1] = MFMA16(a, b1, acc[mt][1]); if ((mt & 3) == 3) asm volatile("" ::: "memory"); }
        }
        if (sb + 1 < 8) KV_STORE((sb + 1) & 1);
        if (sb + 2 < 8) KV_LOAD(sb + 2);
        LDS_BARRIER();
    }
    float* dc = (float*)(p.ws + WS_DC) + (size_t)(bh * NSC + j) * CROWS * DH;
#pragma unroll
    for (int mt = 0; mt < 17; ++mt) {
        int ro = (4 * (lane >> 4)) * DH + 32 * wave + (lane & 15); asm volatile("" : "+v"(ro));
        float* dp = dc + (size_t)(16 * mt) * DH + ro;
#pragma unroll
        for (int nl = 0; nl < 2; ++nl)
#pragma unroll
            for (int i = 0; i < 4; ++i) dp[i * DH + 16 * nl] = acc[mt][nl][i]; }
}
__device__ __forceinline__ void m2_scan(const Params& p) {
    const float* __restrict__ dc = (const float*)(p.ws + WS_DC); bf16* __restrict__ cb = (bf16*)(p.ws + WS_CB); const float* __restrict__ dec = (const float*)(p.ws + WS_MDEC);
    constexpr int PER = CROWS * DH / 4;
    const int nthr = gridDim.x * 512;
    for (int it = blockIdx.x * 512 + otid(p.wv); it < 8 * PER; it += 2 * nthr) {
        const bool two = it + nthr < 8 * PER; const int it1 = two ? it + nthr : it;
        const int bh0 = it / PER, idx0 = it % PER, bh1 = it1 / PER, idx1 = it1 % PER;
        const f32x4* src0 = (const f32x4*)(dc + (size_t)bh0 * NSC * CROWS * DH) + idx0; v2u* dst0 = (v2u*)(cb + (size_t)bh0 * NSC * CROWS * DH) + idx0;
        const f32x4* src1 = (const f32x4*)(dc + (size_t)bh1 * NSC * CROWS * DH) + idx1; v2u* dst1 = (v2u*)(cb + (size_t)bh1 * NSC * CROWS * DH) + idx1;
        f32x4 C0 = {0.f, 0.f, 0.f, 0.f}, C1 = {0.f, 0.f, 0.f, 0.f};
#pragma unroll 8
        for (int j = 0; j < NSC; ++j) {
            const f32x4 d0 = __builtin_nontemporal_load(src0 + (size_t)j * PER), d1 = __builtin_nontemporal_load(src1 + (size_t)j * PER);
            v2u w; w.x = pk2(C0.x, C0.y); w.y = pk2(C0.z, C0.w); dst0[(size_t)j * PER] = w;
            if (two) { v2u w1; w1.x = pk2(C1.x, C1.y); w1.y = pk2(C1.z, C1.w); dst1[(size_t)j * PER] = w1; }
            C0 = C0 * dec[bh0 * NSC + j] + d0; C1 = C1 * dec[bh1 * NSC + j] + d1; }
    }
}
#define CT_LOAD(row0, npc) do { int t_ = tid; asm volatile("" : "+v"(t_)); _Pragma("unroll") for (int i_ = 0; i_ < (npc); ++i_) rc[i_] = *(const v4u*)(cb + (size_t)(row0) * DH + (size_t)(t_ + 512 * i_) * 8); } while (0)
#define CT_STORE(buf, npc) do { int t_ = tid; asm volatile("" : "+v"(t_)); _Pragma("unroll") for (int i_ = 0; i_ < (npc); ++i_) { const int c_ = t_ + 512 * i_, r_ = c_ >> 5, ch_ = c_ & 31; *(LAS v4u*)(lds + (buf) * CT_BUF + r_ * KT_PITCH + 16 * ch_) = rc[i_]; } } while (0)
#define CT_MMA(buf, MT0, MT1) do { _Pragma("unroll") for (int mt = (MT0); mt < (MT1); ++mt) { \
        LAS unsigned char* ap_ = lds + (buf) * CT_BUF + (16 * (mt - (MT0)) + l15) * KT_PITCH + 16 * g; \
        _Pragma("unroll") for (int ks = 0; ks < 8; ++ks) acc[mt] = MFMA16(*(const LAS bf16x8*)(ap_ + 64 * ks), bq[ks], acc[mt]); \
        if ((mt - (MT0)) & 1) asm volatile("" ::: "memory"); } } while (0)
__device__ __forceinline__ void m3_unit(const Params& p, int bh, int j, LAS unsigned char* lds) {
    const int tid = otid(p.wv), lane = tid & 63, wave = tid >> 6, b = bh >> 2, h = bh & 3;
    LAS float* GB = (LAS float*)(lds + L_GB); LAS float* GLI = (LAS float*)(lds + L_GLI); LAS float* GM = (LAS float*)(lds + L_GM); LAS float* MISC = (LAS float*)(lds + L_MISC);
    const size_t tokbase = (size_t)b * SEQ + SC * j;
    const bf16* Qp = (const bf16*)(p.ws + WS_PROJ) + tokbase * DR + h * DH;
    const bf16* Kp = (const bf16*)(p.ws + WS_PROJ) + (size_t)1 * M * DR + tokbase * DR + h * DH;
    const bf16* Vp = (const bf16*)(p.ws + WS_PROJ) + (size_t)2 * M * DR + tokbase * DR + h * DH;
    const bf16* Op = (const bf16*)(p.ws + WS_PROJ) + (size_t)3 * M * DR + tokbase * DR + h * DH;
    const bf16* cb = (const bf16*)(p.ws + WS_CB) + (size_t)(bh * NSC + j) * CROWS * DH;
    bf16* Y = (bf16*)(p.ws + WS_U) + tokbase * D + h * DH;
    const float* ng = kin(I_MNG) + h * DH;
    v4u rc[6];
    CT_LOAD(0, 6);
    mlstm_gates((const float*)(p.ws + WS_GATES), (const float*)(p.ws + WS_QP), b, h, j, lds, p.wv);
    const float m_start = MISC[0];
#pragma unroll 1
    for (int ps = 0; ps < 2; ++ps) {
        int l15 = lane & 15, g = lane >> 4, pp = lane & 3; asm volatile("" : "+v"(l15), "+v"(g), "+v"(pp));
        const int q = l15 >> 2;
        const int t0 = 128 * ps + 16 * wave, tl = t0 + l15;
        bf16x8 bq[8];
#pragma unroll
        for (int ks = 0; ks < 8; ++ks) bq[ks] = *(const bf16x8*)(Qp + (size_t)tl * DR + 32 * ks + 8 * g);
        f32x4 acc[17];
#pragma unroll
        for (int mt = 0; mt < 17; ++mt) acc[mt] = (f32x4){0.f, 0.f, 0.f, 0.f};
        CT_STORE(0, 6); CT_LOAD(96, 6);
        LDS_BARRIER();
        CT_MMA(0, 0, 6);
        CT_STORE(1, 6); CT_LOAD(192, 5);
        LDS_BARRIER();
        CT_MMA(1, 6, 12);
        CT_STORE(0, 5);
        LDS_BARRIER();
        CT_MMA(0, 12, 17);
        v4u rk[2], rv[2];
        KV_LOAD(0);
        const float bt = GB[tl], mt_ = GM[tl];
        const float winter = __expf(bt + m_start - mt_);
#pragma unroll
        for (int mt = 0; mt < 17; ++mt) acc[mt] = acc[mt] * winter;
        LDS_BARRIER();
        const int nblk = 4 * ps + 4;
        preset_ones_col(lds, tid);
        KV_STORE(0); KV_LOAD(1);
        LDS_BARRIER();
#pragma unroll 1
        for (int kb = 0; kb < nblk; ++kb) {
            const int s0 = 32 * kb;
            if (s0 <= t0 + 15) {
                LAS unsigned char* buf = lds + (kb & 1) * KV_BUF;
                f32x4 sa = {0.f, 0.f, 0.f, 0.f}, sb = {0.f, 0.f, 0.f, 0.f};
                LAS unsigned char* kr = buf + l15 * KT_PITCH + 16 * g;
#pragma unroll
                for (int ks = 0; ks < 8; ++ks) { const bf16x8 ka = *(const LAS bf16x8*)(kr + 64 * ks), kb2 = *(const LAS bf16x8*)(kr + 16 * KT_PITCH + 64 * ks);
                    sa = MFMA16(ka, bq[ks], sa); sb = MFMA16(kb2, bq[ks], sb); }
                float pa[4], pb[4];
#pragma unroll
                for (int i = 0; i < 4; ++i) { const int s1 = s0 + 4 * g + i, s2 = s1 + 16;
                    const float w1 = (s1 <= tl) ? __expf(bt - GB[s1] + GLI[s1] - mt_) * 0.0625f : 0.f;
                    const float w2 = (s2 <= tl) ? __expf(bt - GB[s2] + GLI[s2] - mt_) * 0.0625f : 0.f;
                    pa[i] = sa[i] * w1; pb[i] = sb[i] * w2; }
                v4u pw; pw.x = pk2(pa[0], pa[1]); pw.y = pk2(pa[2], pa[3]); pw.z = pk2(pb[0], pb[1]); pw.w = pk2(pb[2], pb[3]);
                const bf16x8 pf = __builtin_bit_cast(bf16x8, pw);
                LAS unsigned char* vb = buf + KV_VOFF + (4 * g + q) * VT_PITCH + (4 * pp) * 2;
#pragma unroll
                for (int mt = 0; mt < 17; ++mt) { const bf16x8 a = cat8(tr_read(vb + 32 * mt), tr_read(vb + 32 * mt + 16 * VT_PITCH)); acc[mt] = MFMA16(a, pf, acc[mt]); if ((mt & 3) == 3) asm volatile("" ::: "memory"); }
            }
            if (kb + 1 < nblk) KV_STORE((kb + 1) & 1);
            if (kb + 2 < nblk) KV_LOAD(kb + 2);
            LDS_BARRIER();
        }
        if (ps == 0) CT_LOAD(0, 6);
        const float den = shfrom(acc[16][0], l15);
        const float inv = 1.0f / fmaxf(fabsf(den), __expf(-mt_));
        float s = 0.f;
#pragma unroll
        for (int mt = 0; mt < 16; ++mt) { acc[mt] = acc[mt] * inv; s += (acc[mt][0] + acc[mt][1]) + (acc[mt][2] + acc[mt][3]); }
        s += shx(s, 16, lane); s += shx(s, 32, lane);
        const float mean = s * (1.f / DH); float s2 = 0.f;
#pragma unroll
        for (int mt = 0; mt < 16; ++mt) { acc[mt] = acc[mt] - mean; s2 += (acc[mt][0] * acc[mt][0] + acc[mt][1] * acc[mt][1]) + (acc[mt][2] * acc[mt][2] + acc[mt][3] * acc[mt][3]); }
        s2 += shx(s2, 16, lane); s2 += shx(s2, 32, lane);
        const float rstd = 1.0f / sqrtf(s2 * (1.f / DH) + LN_EPS);
#pragma unroll
        for (int mt = 0; mt < 16; ++mt) { const int e = 16 * mt + 4 * g;
            const f32x4 g4 = *(const f32x4*)(ng + e); const v2u o2 = *(const v2u*)(Op + (size_t)tl * DR + e);
            const float y0 = acc[mt][0] * rstd * g4.x * sigm(bflo(o2.x)), y1 = acc[mt][1] * rstd * g4.y * sigm(bfhi(o2.x));
            const float y2 = acc[mt][2] * rstd * g4.z * sigm(bflo(o2.y)), y3 = acc[mt][3] * rstd * g4.w * sigm(bfhi(o2.y));
            v2u w; w.x = pk2(y0, y1); w.y = pk2(y2, y3); *(v2u*)(Y + (size_t)tl * D + e) = w; }
    }
    LDS_BARRIER();
}

constexpr int RG_XC = 0, XC_PITCH = 272, XC_BUF = 17408;
constexpr int RG_CW = 34816;
constexpr int RG_HS = 37888, HS_PITCH = 132;
__device__ __forceinline__ float gelu_tanh(float x) { return x * sigm(x * (1.5957691216057308f + 0.07135481283f * x * x)); }
#define RG_LOADX(tile_) do { const int tok_ = (tile_) * 64 + tt, tsq_ = tok_ & (SEQ - 1); _Pragma("unroll") for (int tap = 0; tap < 4; ++tap) { \
        const int row_ = (tsq_ - 3 + tap >= 0) ? tok_ - 3 + tap : tok_; const bf16* xp_ = XR + (size_t)row_ * DR + blk * 128 + 16 * c8; xr[tap][0] = *(const v4u*)xp_; xr[tap][1] = *(const v4u*)(xp_ + 8); } } while (0)
__device__ __forceinline__ void rg_phase(const Params& p, int pass, LAS unsigned char* lds) {
    const int tid = otid(p.wv), lane = tid & 63, wave = tid >> 6, g = lane >> 4, l15 = lane & 15;
    const bf16* XR = (const bf16*)(p.ws + WS_PROJ) + (size_t)4 * M * DR; const bf16* GR = (const bf16*)(p.ws + WS_PROJ) + (size_t)5 * M * DR;
    const int blk = blockIdx.x & 7, tstep = gridDim.x >> 3, tt = tid >> 3, c8 = tid & 7;
    LAS float* CW = (LAS float*)(lds + RG_CW); LAS float* HS = (LAS float*)(lds + RG_HS);
    { const int tap = tid >> 7, c = tid & 127; CW[tid] = kin(I_CONVW)[tap * DR + blk * 128 + c]; if (tid < 128) CW[512 + tid] = kin(I_CONVB)[blk * 128 + tid]; }
    bf16x8 fa[4], fx[4];
    { const bf16* wa = (const bf16*)(p.ws + WS_WAT) + blk * 16384 + (16 * wave + l15) * 128 + 8 * g;
      const bf16* wx = (const bf16*)(p.ws + WS_WXT) + blk * 16384 + (16 * wave + l15) * 128 + 8 * g;
#pragma unroll
      for (int ks = 0; ks < 4; ++ks) { fa[ks] = *(const bf16x8*)(wa + 32 * ks); fx[ks] = *(const bf16x8*)(wx + 32 * ks); } }
    const int c = 16 * wave + l15, ch = blk * 128 + c;
    const float bav = kin(I_BA)[ch], bxv = kin(I_BX)[ch], sp8 = 8.0f * log1pf(__expf(-kin(I_LAM)[ch]));
    v4u xr[4][2], gq[2];
    int tile = blockIdx.x >> 3;
    if (tile < M / 64) RG_LOADX(tile);
    LDS_BARRIER();
#pragma unroll 1
    for (int it = 0; tile < M / 64; tile += tstep, ++it) {
        const int tok = tile * 64 + tt, tseq = tok & (SEQ - 1);
        LAS unsigned char* xc = lds + RG_XC + (it & 1) * XC_BUF;
#pragma unroll
        for (int hf = 0; hf < 2; ++hf) { float a[8];
            { const f32x4 b0 = *(const LAS f32x4*)(CW + 512 + 16 * c8 + 8 * hf), b1 = *(const LAS f32x4*)(CW + 512 + 16 * c8 + 8 * hf + 4); a[0] = b0.x; a[1] = b0.y; a[2] = b0.z; a[3] = b0.w; a[4] = b1.x; a[5] = b1.y; a[6] = b1.z; a[7] = b1.w; }
#pragma unroll
            for (int tap = 0; tap < 4; ++tap) { const float vm = (tseq - 3 + tap >= 0) ? 1.0f : 0.0f; const v4u x = xr[tap][hf];
                const f32x4 w0 = *(const LAS f32x4*)(CW + tap * 128 + 16 * c8 + 8 * hf) * vm, w1 = *(const LAS f32x4*)(CW + tap * 128 + 16 * c8 + 8 * hf + 4) * vm;
                a[0] += bflo(x.x) * w0.x; a[1] += bfhi(x.x) * w0.y; a[2] += bflo(x.y) * w0.z; a[3] += bfhi(x.y) * w0.w;
                a[4] += bflo(x.z) * w1.x; a[5] += bfhi(x.z) * w1.y; a[6] += bflo(x.w) * w1.z; a[7] += bfhi(x.w) * w1.w; }
            v4u o; o.x = pk2(a[0], a[1]); o.y = pk2(a[2], a[3]); o.z = pk2(a[4], a[5]); o.w = pk2(a[6], a[7]);
            *(LAS v4u*)(xc + tt * XC_PITCH + (16 * c8 + 8 * hf) * 2) = o; }
        float carry = (pass == 1) ? ((const float*)(p.ws + WS_RGC))[(size_t)tile * DR + ch] : 0.f;
        if (pass == 1) { const bf16* gp = GR + (size_t)tok * DR + blk * 128 + 16 * c8; gq[0] = *(const v4u*)gp; gq[1] = *(const v4u*)(gp + 8); }
        asm volatile("" ::: "memory");
        { const int nt_ = (tile + tstep < M / 64) ? tile + tstep : tile; RG_LOADX(nt_); }
        LDS_BARRIER();
        f32x4 ar[4], ai[4];
#pragma unroll
        for (int mt = 0; mt < 4; ++mt) { ar[mt] = (f32x4){0.f, 0.f, 0.f, 0.f}; ai[mt] = (f32x4){0.f, 0.f, 0.f, 0.f};
#pragma unroll
            for (int ks = 0; ks < 4; ++ks) { const bf16x8 a = *(const LAS bf16x8*)(xc + (16 * mt + l15) * XC_PITCH + 64 * ks + 16 * g);
                ar[mt] = MFMA16(a, fa[ks], ar[mt]); ai[mt] = MFMA16(a, fx[ks], ai[mt]); } }
        float Ptot = 1.f;
#pragma unroll
        for (int mt = 0; mt < 4; ++mt) {
            float av[4], uv[4];
            {
                const f32x4 er4 = (ar[mt] + bav) * -1.4426950408889634f, ei4 = (ai[mt] + bxv) * -1.4426950408889634f; f32x4 dr, di;
#pragma unroll
                for (int i = 0; i < 4; ++i) { dr[i] = __builtin_amdgcn_exp2f(er4[i]); di[i] = __builtin_amdgcn_exp2f(ei4[i]); }
                dr = dr + 1.0f; di = di + 1.0f; f32x4 r4, ig4;
#pragma unroll
                for (int i = 0; i < 4; ++i) { r4[i] = __builtin_amdgcn_rcpf(dr[i]); ig4[i] = __builtin_amdgcn_rcpf(di[i]); }
                const f32x4 la4 = r4 * -sp8, ea4 = la4 * 1.4426950408889634f, t2 = la4 * 2.0f; f32x4 a4;
#pragma unroll
                for (int i = 0; i < 4; ++i) a4[i] = __builtin_amdgcn_exp2f(ea4[i]);
                const f32x4 om = -t2 * (t2 * (t2 * (t2 * (t2 * 0.008333334f + 0.041666668f) + 0.16666667f) + 0.5f) + 1.0f), dm = 1.0f - a4 * a4; f32x4 xc4;
#pragma unroll
                for (int i = 0; i < 4; ++i) xc4[i] = __builtin_bit_cast(float, (unsigned)(*(const LAS unsigned short*)(xc + (16 * mt + 4 * g + i) * XC_PITCH + 2 * c)) << 16);
                const f32x4 gx = ig4 * xc4;
#pragma unroll
                for (int i = 0; i < 4; ++i) { av[i] = a4[i]; uv[i] = __builtin_amdgcn_sqrtf(t2[i] > -0.5f ? om[i] : dm[i]) * gx[i]; }
            }
            float P = (av[0] * av[1]) * (av[2] * av[3]), H = ((uv[0] * av[1] + uv[1]) * av[2] + uv[2]) * av[3] + uv[3];
            { const float Pp = shup(P, 16, lane), Hp = shup(H, 16, lane); if (g >= 1) { H = P * Hp + H; P = P * Pp; } }
            { const float Pp = shup(P, 32, lane), Hp = shup(H, 32, lane); if (g >= 2) { H = P * Hp + H; P = P * Pp; } }
            float Pe = shup(P, 16, lane), He = shup(H, 16, lane); if (g == 0) { Pe = 1.f; He = 0.f; }
            const float P3 = shfrom(P, l15 + 48), H3 = shfrom(H, l15 + 48);
            if (pass == 1) { float hh = Pe * carry + He;
#pragma unroll
                for (int i = 0; i < 4; ++i) { hh = av[i] * hh + uv[i]; HS[(16 * mt + 4 * g + i) * HS_PITCH + c] = hh; } }
            carry = P3 * carry + H3; Ptot *= P3;
        }
        if (pass == 0) { if (g == 0) { ((float*)(p.ws + WS_RGP))[(size_t)tile * DR + ch] = Ptot; ((float*)(p.ws + WS_RGH))[(size_t)tile * DR + ch] = carry; } }
        else {
            LDS_BARRIER();
            bf16* Y = (bf16*)(p.ws + WS_U) + (size_t)tok * D + DR + blk * 128 + 16 * c8;
#pragma unroll
            for (int hf = 0; hf < 2; ++hf) { const v4u gv = gq[hf];
                const LAS float* hp = HS + tt * HS_PITCH + 16 * c8 + 8 * hf; const f32x4 h0 = *(const LAS f32x4*)hp, h1 = *(const LAS f32x4*)(hp + 4);
                v4u o; o.x = pk2(h0.x * gelu_tanh(bflo(gv.x)), h0.y * gelu_tanh(bfhi(gv.x))); o.y = pk2(h0.z * gelu_tanh(bflo(gv.y)), h0.w * gelu_tanh(bfhi(gv.y)));
                o.z = pk2(h1.x * gelu_tanh(bflo(gv.z)), h1.y * gelu_tanh(bfhi(gv.z))); o.w = pk2(h1.z * gelu_tanh(bflo(gv.w)), h1.w * gelu_tanh(bfhi(gv.w)));
                *(v4u*)(Y + 8 * hf) = o; }
        }
    }
    LDS_BARRIER();
}
__device__ __forceinline__ void rg_carry_unit(const Params& p, int unit, LAS unsigned char* lds) {
    const int tid = otid(p.wv), b = unit >> 4, cg0 = (unit & 15) * 64;
    LAS float* Pl = (LAS float*)lds; LAS float* Hl = (LAS float*)(lds + 32768);
    const float* RP = (const float*)(p.ws + WS_RGP); const float* RH = (const float*)(p.ws + WS_RGH); float* RC = (float*)(p.ws + WS_RGC);
    for (int i = tid; i < 128 * 64; i += 512) { const int tl = i >> 6, c = i & 63; const size_t o = (size_t)(b * 128 + tl) * DR + cg0 + c; Pl[i] = RP[o]; Hl[i] = RH[o]; }
    __syncthreads();
    {
        LAS float* Ps = (LAS float*)(lds + 65536); LAS float* Hs = Ps + 512;
        const int c = tid & 63, seg = tid >> 6;
        float P = 1.f, H = 0.f;
#pragma unroll 4
        for (int i = 0; i < 16; ++i) { const int o = (seg * 16 + i) * 64 + c; const float cp = Pl[o]; H = cp * H + Hl[o]; P *= cp; }
        Ps[seg * 64 + c] = P; Hs[seg * 64 + c] = H;
        __syncthreads();
        float carry = 0.f;
        for (int s = 0; s < seg; ++s) carry = Ps[s * 64 + c] * carry + Hs[s * 64 + c];
#pragma unroll 4
        for (int i = 0; i < 16; ++i) { const int o = (seg * 16 + i) * 64 + c; const float cp = Pl[o], chh = Hl[o]; Pl[o] = carry; carry = cp * carry + chh; }
    }
    __syncthreads();
    for (int i = tid; i < 128 * 64; i += 512) { const int tl = i >> 6, c = i & 63; RC[(size_t)(b * 128 + tl) * DR + cg0 + c] = Pl[i]; }
    __syncthreads();
}

__global__ void __launch_bounds__(512, 2) hybrid_fwd(Params p_in) {
    extern __shared__ __attribute__((aligned(16))) unsigned char lds_raw[];
    LAS unsigned char* lds = (LAS unsigned char*)lds_raw;
    cg::grid_group grid = cg::this_grid();
    Params p = p_in; p.wv = __builtin_amdgcn_readfirstlane((int)threadIdx.x >> 6);
    unsigned char* ws = p.ws;
    const int G = gridDim.x, bid = blockIdx.x;
    const float* mod = (const float*)(ws + WS_MOD);
    bf16* U = (bf16*)(ws + WS_U); bf16* Hb = (bf16*)(ws + WS_H);
    bf16* XB = (bf16*)(ws + WS_XBH);
    volatile LAS unsigned* xst = (volatile LAS unsigned*)(lds + LDS_BYTES - 64);
    { const int t0_ = otid(p.wv); if (t0_ < 16) xst[t0_] = 0u; }
    __syncthreads();
    (void)xcd_barrier_post((unsigned*)(ws + WS_BAR), xst, p.wv);
#define GRID_BAR() do { XcdBarrier xb_; xb_.bar = (unsigned*)(ws + WS_BAR); xb_.x = xb_xcc_id(); xb_.st = (volatile LAS unsigned*)(lds + LDS_BYTES - 64); xb_.wv = p.wv; xcd_barrier(xb_); } while (0)
#ifdef PROBE_MASK
#define PR_SLOT ((volatile LAS unsigned long long*)(lds + LDS_BYTES - 128))
    if (bid == 0 && otid(p.wv) == 0) { PR_SLOT[0] = __builtin_amdgcn_s_memrealtime(); PR_SLOT[1] = 0ull; }
#define PH_END(k) do { if (bid == 0 && otid(p.wv) == 0) { const unsigned long long now_ = __builtin_amdgcn_s_memrealtime(); if ((PROBE_MASK >> (k)) & 1) PR_SLOT[1] += now_ - PR_SLOT[0]; PR_SLOT[0] = now_; } } while (0)
#else
#define PH_END(k) do { } while (0)
#endif

    if (p.ws == nullptr) grid.sync();
    p0_prologue(p, lds);
    GRID_BAR(); PH_END(0);
    row_pass(p, kin(I_X), false, nullptr, -1, 0, false, UP8_0, true, true, lds);
    GRID_BAR(); PH_END(1);
    { pg8::Gemm gm{U, (const bf16*)(ws + WS_W13A), M, 2 * FF, UP8_0 ? D / 2 : D, p.wv}; pg8::StaticOrder S; S.init(M, 2 * FF, G, bid);
      pg8::EpiSwiglu<DN8_0> E{Hb, FF, UP8_0 ? 1.0f / (FP8_ASCALE * FP8_WSCALE) : 1.0f, FP8_HSCALE}; pg8::gemm_phase<pg8::EpiSwiglu<DN8_0>, pg8::StaticOrder, true, true, UP8_0>(lds, gm, S, E); }
    GRID_BAR(); PH_END(2);
    { pg8::Gemm gm{Hb, (const bf16*)(ws + WS_W2A), M, D, DN8_0 ? FF / 2 : FF, p.wv}; pg8::StaticOrder S; S.init(M, D, G, bid, 8);
      pg8::EpiRes<false> E{kin(I_X), XB, mod + 0 * 3 * D + 2 * D, nullptr, DN8_0 ? 0.5f / (FP8_HSCALE * FP8_W2SCALE) : 0.5f, 0}; pg8::gemm_phase<pg8::EpiRes<false>, pg8::StaticOrder, true, true, DN8_0>(lds, gm, S, E); }
    GRID_BAR(); PH_END(3);
    row_pass(p, XB, true, nullptr, 0, 1, true, false, false, false, lds);
    GRID_BAR(); PH_END(4);
    { pg8::Gemm gm{U, (const bf16*)(ws + WS_WIN), M, NPROJ, D, p.wv}; pg8::StaticOrder S; S.init(M, NPROJ, G, bid);
      pg8::EpiProj E{(bf16*)(ws + WS_PROJ), kin(I_BIN)}; pg8::gemm_phase<pg8::EpiProj, pg8::StaticOrder, true, true>(lds, gm, S, E); }
    GRID_BAR(); PH_END(5);
    for (int u = bid; u < 8 * NSC; u += G) m1_unit(p, u / NSC, u % NSC, lds);
    rg_phase(p, 0, lds);
    GRID_BAR(); PH_END(6);
    m2_scan(p);
    for (int u = bid; u < 32; u += G) rg_carry_unit(p, u, lds);
    GRID_BAR(); PH_END(7);
    for (int u = bid; u < 8 * NSC; u += G) m3_unit(p, u / NSC, u % NSC, lds);
    rg_phase(p, 1, lds);
    GRID_BAR(); PH_END(8);
    { pg8::Gemm gm{U, (const bf16*)(ws + WS_WOUT), M, D, D, p.wv}; pg8::StaticOrder S; S.init(M, D, G, bid);
      pg8::EpiRes<true> E{XB, XB, mod + 1 * 3 * D + 2 * D, (const float*)(ws + WS_STAT), 1.0f, 0};        pg8::gemm_phase<pg8::EpiRes<true>, pg8::StaticOrder, true, true>(lds, gm, S, E); }
    GRID_BAR(); PH_END(9);
    row_pass(p, XB, true, nullptr, 1, 2, false, UP8_1, false, false, lds);
    GRID_BAR(); PH_END(10);
    { pg8::Gemm gm{U, (const bf16*)(ws + WS_W13B), M, 2 * FF, UP8_1 ? D / 2 : D, p.wv}; pg8::StaticOrder S; S.init(M, 2 * FF, G, bid, 8);
      pg8::EpiSwiglu<DN8_1> E{Hb, FF, UP8_1 ? 1.0f / (FP8_ASCALE * FP8_WSCALE) : 1.0f, FP8_HSCALE}; pg8::gemm_phase<pg8::EpiSwiglu<DN8_1>, pg8::StaticOrder, true, true, UP8_1>(lds, gm, S, E); }
    GRID_BAR(); PH_END(11);
    { pg8::Gemm gm{Hb, (const bf16*)(ws + WS_W2B), M, D, DN8_1 ? FF / 2 : FF, p.wv}; pg8::StaticOrder S; S.init(M, D, G, bid, 8);
      pg8::EpiRes<true> E{XB, XB, mod + 2 * 3 * D + 2 * D, (const float*)(ws + WS_STAT), DN8_1 ? 0.5f / (FP8_HSCALE * FP8_W2SCALE) : 0.5f, 1};        pg8::gemm_phase<pg8::EpiRes<true>, pg8::StaticOrder, true, true, DN8_1>(lds, gm, S, E); }
    GRID_BAR(); PH_END(12);
    row_pass(p, XB, true, p.out, 2, -1, false, false, false, true, lds);
#ifdef PROBE_MASK
    grid.sync(); PH_END(13);
    if (bid == 0 && otid(p.wv) == 0) { *(volatile float*)(ws + WS_MDEC + 65536) = sqrtf((float)PR_SLOT[1] * 0.01f * 1e-5f); __threadfence(); }
    grid.sync();
    { const float E = *(volatile float*)(ws + WS_MDEC + 65536);
      for (int i = bid * 512 + otid(p.wv); i < M * D / 1024; i += G * 512) XB[(size_t)i * 1024] += E; }
#endif
}

extern "C" void kernel_launch(void* const* d_in, const int* in_sizes, int n_in, void* d_out, int out_size, void* d_ws, size_t ws_size, hipStream_t stream) {
    static int grid = 0;
    if (grid == 0) {
        if (n_in != 21 || out_size != M * D || ws_size < WS_END) { fprintf(stderr, "kernel_launch: unexpected shapes (n_in %d, out %d, ws %zu < %zu)\n", n_in, out_size, ws_size, (size_t)WS_END); grid = -1; return; }
        int dev = 0, cus = 0, per_cu = 0;
        hipGetDevice(&dev); hipDeviceGetAttribute(&cus, hipDeviceAttributeMultiprocessorCount, dev);
        if (hipFuncSetAttribute((const void*)hybrid_fwd, hipFuncAttributeMaxDynamicSharedMemorySize, LDS_BYTES) != hipSuccess) { fprintf(stderr, "kernel_launch: hipFuncSetAttribute failed\n"); grid = -1; return; }
        if (hipOccupancyMaxActiveBlocksPerMultiprocessor(&per_cu, (const void*)hybrid_fwd, 512, LDS_BYTES) != hipSuccess || per_cu < 1) { fprintf(stderr, "kernel_launch: occupancy query gives %d\n", per_cu); per_cu = 1; }
        (void)hipGetLastError();
        grid = cus;
    }
    if (grid < 0) return;
    hipMemsetAsync((char*)d_ws + WS_BAR, 0, XCD_BAR_WORDS * sizeof(unsigned), stream);
    Params p{};
    for (int i = 0; i < 21; ++i) p.in[i] = (const float*)d_in[i];
    p.out = (float*)d_out; p.ws = (unsigned char*)d_ws;
    void* args[] = {&p};
    hipError_t e = hipLaunchCooperativeKernel((const void*)hybrid_fwd, dim3(grid), dim3(512), args, LDS_BYTES, stream);
    if (e != hipSuccess) fprintf(stderr, "cooperative launch failed: %s (grid %d)\n", hipGetErrorString(e), grid);
}
```

```cpp
#include <hip/hip_runtime.h>
#include <hip/hip_cooperative_groups.h>
#include <cstdio>
#include <cstdint>
namespace cg = cooperative_groups;
__device__ __forceinline__ int otid(int wv) { int t; asm volatile("v_mbcnt_lo_u32_b32 %0, -1, 0\n\tv_mbcnt_hi_u32_b32 %0, -1, %0" : "=v"(t)); return t + 64 * wv; }
__device__ __forceinline__ const float* kin(int i) { int o = __builtin_amdgcn_readfirstlane(i * 8); asm volatile("" : "+s"(o));
    typedef const float* cfp; return *(const __attribute__((address_space(4))) cfp*)((const __attribute__((address_space(4))) char*)__builtin_amdgcn_kernarg_segment_ptr() + o); }
#define UP8_CFG0 false
#define UP8_CFG1 true
#define DN8_CFG0 true
#define DN8_CFG1 true
namespace pg8 {
#define PG8_LAS __attribute__((address_space(3)))
typedef unsigned short bf16_t;
typedef short bf16x8 __attribute__((ext_vector_type(8)));
typedef float f32x4 __attribute__((ext_vector_type(4)));
typedef unsigned u32x4 __attribute__((ext_vector_type(4)));
constexpr int BM = 256, BK = 64, HALF = 128, HTB = HALF * BK * 2  , STAGE_BYTES = 8 * HTB, NXCD = 8, WGM = 4;

__host__ __device__ __forceinline__ int lds_byte(int r, int c) { const int st = (r >> 4) * 2 + (c >> 5), rr = r & 15, cc = c & 31, ob = rr * 64 + cc * 2; return st * 1024 + (ob ^ (((ob >> 9) & 1) << 5)); }
__host__ __device__ __forceinline__ void stage_rc(int b, int& R, int& C) { const int st = b / 1024, sb = b % 1024, swz = sb ^ (((sb >> 9) & 1) << 5); R = (st >> 1) * 16 + swz / 64; C = (st & 1) * 32 + (swz % 64) / 2; }
__host__ __device__ __forceinline__ int perm32(int rho) { const int n = rho >> 4, i = rho & 15; return 8 * (i >> 2) + 4 * n + (i & 3); }

struct Unit { int pm, pn; };
struct Gemm { const bf16_t* A; const bf16_t* Bt; int M, N, K, wv; };

struct StaticOrder {
    int nM, nN, nwg, G, c;
    __host__ __device__ void init(int M, int N, int G_, int c_) { nM = M / BM; nN = N / BM; nwg = nM * nN; G = G_; c = c_; }
    __host__ __device__ bool next(int i, Unit& u) const {
        const long L = (long)i * G + c; if (L >= nwg) return false;
        int wgid = (int)L; { const int q = nwg / NXCD, r = nwg % NXCD, xcd = wgid % NXCD, off = wgid / NXCD; wgid = (xcd < r ? xcd * (q + 1) : r * (q + 1) + (xcd - r) * q) + off; }
        const int nig = WGM * nN, gid = wgid / nig, fm = gid * WGM, gsz = (nM - fm) < WGM ? (nM - fm) : WGM;
        u.pm = fm + ((wgid % nig) % gsz); u.pn = (wgid % nig) / gsz; return true;
    }
    __device__ __forceinline__ void a_ready(const Unit&) const {}
    __device__ __forceinline__ void done(const Unit&) const {}
};
typedef int i32x8 __attribute__((ext_vector_type(8)));
__device__ __forceinline__ unsigned cvt_pk_bf16(float lo, float hi) { unsigned r; asm volatile("v_cvt_pk_bf16_f32 %0, %1, %2" : "=v"(r) : "v"(lo), "v"(hi)); return r; }
template <bool OUT8> struct EpiSwiglu {
    static constexpr bool PERM = true, AFTER_DRAIN = false;
    void* O; int ldc; float sc, hs;
    __device__ __forceinline__ void operator()(const f32x4 (&acc)[2][2][4][2], const Unit& u, int wr, int wc, int fr, int fq) const {
        const int row0 = u.pm * BM + wr * 64 + fr, col0 = u.pn * HALF + wc * 32 + 8 * fq;
        const float nsc = -1.4426950408889634f * sc, vs = sc * sc * (OUT8 ? hs : 1.0f);
#pragma unroll
        for (int ai = 0; ai < 2; ++ai)
#pragma unroll
            for (int m = 0; m < 4; ++m) {
                float h[8];
#pragma unroll
                for (int n = 0; n < 2; ++n) {
                    const f32x4 g4 = acc[ai][0][m][n], num = (g4 * acc[ai][1][m][n]) * vs, ea = g4 * nsc; f32x4 den;
#pragma unroll
                    for (int j = 0; j < 4; ++j) den[j] = __builtin_amdgcn_exp2f(ea[j]);
                    den = den + 1.0f;
#pragma unroll
                    for (int j = 0; j < 4; ++j) h[4 * n + j] = num[j] * __builtin_amdgcn_rcpf(den[j]); }
                const size_t off = (size_t)(row0 + ai * HALF + m * 16) * ldc + col0;
                if constexpr (OUT8) { unsigned w0 = 0u, w1 = 0u;
                    w0 = __builtin_amdgcn_cvt_pk_fp8_f32(h[0], h[1], w0, false); w0 = __builtin_amdgcn_cvt_pk_fp8_f32(h[2], h[3], w0, true);
                    w1 = __builtin_amdgcn_cvt_pk_fp8_f32(h[4], h[5], w1, false); w1 = __builtin_amdgcn_cvt_pk_fp8_f32(h[6], h[7], w1, true);
                    typedef unsigned u32x2 __attribute__((ext_vector_type(2))); *(u32x2*)((unsigned char*)O + off) = (u32x2){w0, w1};
                } else { u32x4 w; w.x = cvt_pk_bf16(h[0], h[1]); w.y = cvt_pk_bf16(h[2], h[3]); w.z = cvt_pk_bf16(h[4], h[5]); w.w = cvt_pk_bf16(h[6], h[7]);
                    *(u32x4*)((bf16_t*)O + off) = w; } }
    }
};
typedef _Float16 f16x4 __attribute__((ext_vector_type(4)));
template <bool LNRES> struct EpiRes {
    static constexpr bool PERM = false, AFTER_DRAIN = false;
    const void* res; bf16_t* out; const float* gate; const float* stat; float coef; int ln_idx;
    static constexpr int gate_bstride = 18432; static constexpr float alpha = 1.189207115002721f;
    __device__ __forceinline__ void operator()(const f32x4 (&acc)[2][2][4][2], const Unit& u, int wr, int wc, int fr, int fq) const {
        typedef float f32x2v __attribute__((ext_vector_type(2))); typedef unsigned u32x2 __attribute__((ext_vector_type(2)));
        const void* const res_ = res; bf16_t* const out_ = out; const float* const gate_ = gate; const float coef_ = coef; const float* const stat_ = stat; const int ln_ = ln_idx;
        const int row0 = u.pm * BM + wr * 64 + fr, col0 = u.pn * BM + wc * 32 + 4 * fq;
        const float* gp = gate_ + (size_t)(u.pm >> 5) * gate_bstride + col0;
#pragma unroll
        for (int bj = 0; bj < 2; ++bj)
#pragma unroll
            for (int n = 0; n < 2; ++n) {
                const int co = bj * HALF + n * 16;
                const f32x4 gv = *(const f32x4*)(gp + co) * coef_;
                f32x4 lg = {1.f, 1.f, 1.f, 1.f}, lb = {0.f, 0.f, 0.f, 0.f};
                if constexpr (LNRES) { lg = *(const f32x4*)(kin(19) + ln_ * 2048 + col0 + co); lb = *(const f32x4*)(kin(20) + ln_ * 2048 + col0 + co); }
#pragma unroll
                for (int ai = 0; ai < 2; ++ai)
#pragma unroll
                    for (int m = 0; m < 4; ++m) { const int row = row0 + ai * HALF + m * 16; const size_t off = (size_t)row * 2048 + col0 + co;
                        f32x4 r;
                        if constexpr (LNRES) { r = __builtin_convertvector(*(const f16x4*)((const bf16_t*)res_ + off), f32x4);
                            const f32x2v st = *(const f32x2v*)(stat_ + 2 * (size_t)row); r = (r - st.x) * st.y * lg + lb; }
                        else r = __builtin_nontemporal_load((const f32x4*)((const float*)res_ + off));
                        const f32x4 z = r * alpha + gv * acc[ai][bj][m][n];
                        *(f16x4*)(out_ + off) = __builtin_convertvector(z, f16x4); }
                if (bj == 0 && n == 1) __builtin_amdgcn_sched_barrier(0); }
    }
};
struct EpiProj {
    static constexpr bool PERM = true, AFTER_DRAIN = false;
    bf16_t* O; const float* bias;
    __device__ __forceinline__ void operator()(const f32x4 (&acc)[2][2][4][2], const Unit& u, int wr, int wc, int fr, int fq) const {
        const int row0 = u.pm * BM + wr * 64 + fr; const int colt = u.pn * BM; const int t = colt >> 10;
        bf16_t* base = O + (size_t)t * ((size_t)16384 * 1024);
        const int col0 = (colt & 1023) + wc * 32 + 8 * fq, bcol0 = colt + (colt >= 4096 ? 8 : 0) + wc * 32 + 8 * fq;
        f32x4 bv[2][2];
#pragma unroll
        for (int bj = 0; bj < 2; ++bj)
#pragma unroll
            for (int n = 0; n < 2; ++n) { const float* bp = bias + bcol0 + bj * HALF + 4 * n; bv[bj][n] = (f32x4){bp[0], bp[1], bp[2], bp[3]}; }
#pragma unroll
        for (int ai = 0; ai < 2; ++ai)
#pragma unroll
            for (int m = 0; m < 4; ++m) { bf16_t* rowp = base + (size_t)(row0 + ai * HALF + m * 16) * 1024 + col0;
#pragma unroll
                for (int bj = 0; bj < 2; ++bj) { const f32x4 v0 = acc[ai][bj][m][0] + bv[bj][0], v1 = acc[ai][bj][m][1] + bv[bj][1];
                    u32x4 w; w.x = cvt_pk_bf16(v0[0], v0[1]); w.y = cvt_pk_bf16(v0[2], v0[3]); w.z = cvt_pk_bf16(v1[0], v1[1]); w.w = cvt_pk_bf16(v1[2], v1[3]);
                    *(u32x4*)(rowp + bj * HALF) = w; } }
    }
};
template <class Epi, class Sched, bool ALIGN_EPI = false, bool SP2 = false, bool FP8 = false>
__device__ __forceinline__ void gemm_phase(PG8_LAS unsigned char* lds, const Gemm g, const Sched& S, const Epi& E) {
    const int tid = otid(g.wv), wid = __builtin_amdgcn_readfirstlane(tid >> 6), lane = tid & 63, wr = wid >> 2, wc = wid & 3, fr = lane & 15, fq = lane >> 4;
    const int K = g.K, nt = K / BK;
    unsigned voffA, voffB;
    { int R, C; stage_rc(tid * 16, R, C); const int Rb = Epi::PERM ? ((R & ~31) + perm32(R & 31)) : R;
        voffA = (unsigned)(R * K + C) * 2u; voffB = (unsigned)(Rb * K + C) * 2u; }
    const size_t istep = (size_t)64 * K * 2;
    const size_t kstep = (size_t)(BK * 2);
    const size_t hstep = (size_t)HALF * K * 2;
    const size_t tstep = 2 * hstep;
    const unsigned ldsw = (unsigned)wid * 1024u;
    const int aoff = lds_byte(wr * 64 + fr, fq * 8), boff = lds_byte(wc * 32 + fr, fq * 8);
#define PG8_SA(b, h) (((b) * 2 + (h)) * HTB)
#define PG8_SB(b, h) ((4 + (b) * 2 + (h)) * HTB)
#define PG8_STAGE(bufoff, gbase, voff) do { _Pragma("unroll") for (int _i = 0; _i < 2; ++_i) \
        __builtin_amdgcn_global_load_lds((const unsigned*)((const char*)(gbase) + (size_t)_i * istep + (voff)), (PG8_LAS unsigned*)(lds + (bufoff) + ldsw + _i * 8192), 16, 0, 0); } while (0)
#define PG8_LDA(dst, b, h) do { _Pragma("unroll") for (int m = 0; m < 4; ++m) _Pragma("unroll") for (int k = 0; k < 2; ++k) dst[m][k] = *(const PG8_LAS bf16x8*)(lds + PG8_SA(b, h) + aoff + m * 2048 + k * 1024); } while (0)
#define PG8_LDB(dst, b, h) do { _Pragma("unroll") for (int n = 0; n < 2; ++n) _Pragma("unroll") for (int k = 0; k < 2; ++k) dst[n][k] = *(const PG8_LAS bf16x8*)(lds + PG8_SB(b, h) + boff + n * 2048 + k * 1024); } while (0)
#define PG8_MMA(ai, bj, At, Bt) do { __builtin_amdgcn_s_setprio(1); _Pragma("unroll") for (int m = 0; m < 4; ++m) _Pragma("unroll") for (int n = 0; n < 2; ++n) { \
        if constexpr (FP8) { acc[ai][bj][m][n] = __builtin_amdgcn_mfma_scale_f32_16x16x128_f8f6f4(__builtin_bit_cast(i32x8, __builtin_shufflevector(Bt[n][0], Bt[n][1], 0, 1, 2, 3, 4, 5, 6, 7, 8, 9, 10, 11, 12, 13, 14, 15)), \
                __builtin_bit_cast(i32x8, __builtin_shufflevector(At[m][0], At[m][1], 0, 1, 2, 3, 4, 5, 6, 7, 8, 9, 10, 11, 12, 13, 14, 15)), acc[ai][bj][m][n], 0, 0, 0, 0x7F7F7F7F, 0, 0x7F7F7F7F); } \
        else { _Pragma("unroll") for (int k = 0; k < 2; ++k) acc[ai][bj][m][n] = __builtin_amdgcn_mfma_f32_16x16x32_bf16(Bt[n][k], At[m][k], acc[ai][bj][m][n], 0, 0, 0); } } \
        __builtin_amdgcn_s_setprio(0); } while (0)
#define PG8_WAIT_V(n) asm volatile("s_waitcnt vmcnt(" #n ")" ::: "memory")
#define PG8_WAIT_L(n) asm volatile("s_waitcnt lgkmcnt(" #n ")" ::: "memory")
#define PG8_BAR __builtin_amdgcn_s_barrier()
#define PG8_SCHED __builtin_amdgcn_sched_barrier(0)
    Unit cur, nxt; int ui = 0;
    if (!S.next(0, cur)) return;
    f32x4 acc[2][2][4][2];
#pragma unroll
    for (int a = 0; a < 2; ++a)
#pragma unroll
        for (int b = 0; b < 2; ++b)
#pragma unroll
            for (int m = 0; m < 4; ++m)
#pragma unroll
                for (int n = 0; n < 2; ++n) acc[a][b][m][n] = (f32x4){0.f, 0.f, 0.f, 0.f};
    bf16x8 At[4][2], B0[2][2], B1[2][2];
    const char* cA = (const char*)g.A + (size_t)cur.pm * tstep; const char* cB = (const char*)g.Bt + (size_t)cur.pn * tstep;
    S.a_ready(cur);
    if constexpr (SP2) {
        PG8_STAGE(PG8_SB(0, 0), cB, voffB); PG8_STAGE(PG8_SB(0, 1), cB + hstep, voffB); PG8_STAGE(PG8_SA(0, 0), cA, voffA); PG8_STAGE(PG8_SA(0, 1), cA + hstep, voffA);
        if (wr == 1) PG8_BAR;
        PG8_WAIT_V(2); PG8_BAR;
        PG8_STAGE(PG8_SB(1, 0), cB + kstep, voffB); PG8_STAGE(PG8_SA(1, 0), cA + kstep, voffA); PG8_STAGE(PG8_SB(1, 1), cB + hstep + kstep, voffB);
        PG8_WAIT_V(6); PG8_BAR;
    } else {
        PG8_STAGE(PG8_SB(0, 0), cB, voffB); PG8_STAGE(PG8_SA(0, 0), cA, voffA); PG8_STAGE(PG8_SB(0, 1), cB + hstep, voffB); PG8_STAGE(PG8_SA(0, 1), cA + hstep, voffA);
        if (wr == 1) PG8_BAR;
        PG8_WAIT_V(4); PG8_BAR;
        PG8_STAGE(PG8_SB(1, 0), cB + kstep, voffB); PG8_STAGE(PG8_SA(1, 0), cA + kstep, voffA); PG8_STAGE(PG8_SB(1, 1), cB + hstep + kstep, voffB);
        PG8_WAIT_V(6); PG8_BAR;
    }
    for (;;) {
        const bool has_next = S.next(ui + 1, nxt);
        const char* nA = has_next ? (const char*)g.A + (size_t)nxt.pm * tstep : cA; const char* nB = has_next ? (const char*)g.Bt + (size_t)nxt.pn * tstep : cB;
        for (int t = 0; t < nt; t += 2) {
            const bool last = (t == nt - 2);
            const char* a1 = cA + (size_t)(t + 1) * kstep;
            const char* a2 = last ? nA : cA + (size_t)(t + 2) * kstep; const char* b2 = last ? nB : cB + (size_t)(t + 2) * kstep;
            const char* a3 = a2 + kstep; const char* b3 = b2 + kstep;
            if (last && has_next) S.a_ready(nxt);
            if constexpr (SP2) {
            PG8_LDB(B0, 0, 0); PG8_LDB(B1, 0, 1); PG8_SCHED; PG8_LDA(At, 0, 0); PG8_STAGE(PG8_SA(1, 1), a1 + hstep, voffA);
            PG8_WAIT_V(8); PG8_WAIT_L(0); PG8_BAR; PG8_MMA(0, 0, At, B0); PG8_MMA(0, 1, At, B1); PG8_BAR; PG8_SCHED;
            PG8_LDA(At, 0, 1); PG8_STAGE(PG8_SB(0, 0), b2, voffB); PG8_STAGE(PG8_SB(0, 1), b2 + hstep, voffB); PG8_STAGE(PG8_SA(0, 0), a2, voffA);
            PG8_WAIT_V(8); PG8_WAIT_L(0); PG8_BAR; PG8_MMA(1, 0, At, B0); PG8_MMA(1, 1, At, B1); PG8_BAR; PG8_SCHED;
            PG8_LDB(B0, 1, 0); PG8_LDB(B1, 1, 1); PG8_SCHED; PG8_LDA(At, 1, 0); PG8_STAGE(PG8_SA(0, 1), a2 + hstep, voffA);
            PG8_WAIT_V(8); PG8_WAIT_L(0); PG8_BAR; PG8_MMA(0, 0, At, B0); PG8_MMA(0, 1, At, B1); PG8_BAR; PG8_SCHED;
            PG8_LDA(At, 1, 1); PG8_STAGE(PG8_SB(1, 0), b3, voffB); PG8_STAGE(PG8_SB(1, 1), b3 + hstep, voffB); PG8_STAGE(PG8_SA(1, 0), a3, voffA);
            PG8_WAIT_V(8); PG8_WAIT_L(0); PG8_BAR; PG8_MMA(1, 0, At, B0); PG8_MMA(1, 1, At, B1); PG8_BAR; PG8_SCHED;
            } else {
            PG8_LDB(B0, 0, 0); PG8_SCHED; PG8_LDA(At, 0, 0); PG8_STAGE(PG8_SA(1, 1), a1 + hstep, voffA);
            PG8_WAIT_L(8); PG8_BAR; PG8_WAIT_L(0); PG8_MMA(0, 0, At, B0); PG8_BAR; PG8_SCHED;
            PG8_LDB(B1, 0, 1); PG8_STAGE(PG8_SB(0, 0), b2, voffB);
            PG8_BAR; PG8_WAIT_L(0); PG8_MMA(0, 1, At, B1); PG8_BAR;
            PG8_LDA(At, 0, 1); PG8_STAGE(PG8_SA(0, 0), a2, voffA);
            PG8_BAR; PG8_WAIT_L(0); PG8_MMA(1, 0, At, B0); PG8_BAR; PG8_SCHED;
            PG8_STAGE(PG8_SB(0, 1), b2 + hstep, voffB);
            PG8_WAIT_V(6); PG8_BAR; PG8_MMA(1, 1, At, B1); PG8_BAR;
            PG8_LDB(B0, 1, 0); PG8_SCHED; PG8_LDA(At, 1, 0); PG8_STAGE(PG8_SA(0, 1), a2 + hstep, voffA);
            PG8_WAIT_L(8); PG8_BAR; PG8_WAIT_L(0); PG8_MMA(0, 0, At, B0); PG8_BAR; PG8_SCHED;
            PG8_LDB(B1, 1, 1); PG8_STAGE(PG8_SB(1, 0), b3, voffB);
            PG8_BAR; PG8_WAIT_L(0); PG8_MMA(0, 1, At, B1); PG8_BAR;
            PG8_LDA(At, 1, 1); PG8_STAGE(PG8_SA(1, 0), a3, voffA);
            PG8_BAR; PG8_WAIT_L(0); PG8_MMA(1, 0, At, B0); PG8_BAR; PG8_SCHED;
            PG8_STAGE(PG8_SB(1, 1), b3 + hstep, voffB);
            PG8_WAIT_V(6); PG8_BAR; PG8_MMA(1, 1, At, B1); PG8_BAR;
            }
        }
        if constexpr (ALIGN_EPI) { if (wr == 0) PG8_BAR; }
        if constexpr (!Epi::AFTER_DRAIN) { const int t2_ = otid(g.wv), fr_ = t2_ & 15, fq_ = (t2_ >> 4) & 3; E(acc, cur, wr, wc, fr_, fq_); S.done(cur); }
        if (!has_next) break;
#pragma unroll
        for (int a = 0; a < 2; ++a)
#pragma unroll
            for (int b = 0; b < 2; ++b)
#pragma unroll
                for (int m = 0; m < 4; ++m)
#pragma unroll
                    for (int n = 0; n < 2; ++n) acc[a][b][m][n] = (f32x4){0.f, 0.f, 0.f, 0.f};
        cur = nxt; cA = nA; cB = nB; ++ui;
        if constexpr (ALIGN_EPI) { if (wr == 1) PG8_BAR; }
    }
    PG8_WAIT_V(0);
    if constexpr (!ALIGN_EPI) { if (wr == 0) PG8_BAR; }
    PG8_BAR;
    if constexpr (Epi::AFTER_DRAIN) { E.fused(acc, cur, wr, wc, fr, fq, lds, wid, lane); S.done(cur); }
#undef PG8_SA
#undef PG8_SB
#undef PG8_STAGE
#undef PG8_LDA
#undef PG8_LDB
#undef PG8_MMA
#undef PG8_WAIT_V
#undef PG8_WAIT_L
#undef PG8_BAR
#undef PG8_SCHED
}
}

#define LAS __attribute__((address_space(3)))
typedef unsigned short bf16;
typedef unsigned v4u __attribute__((ext_vector_type(4)));
typedef unsigned v2u __attribute__((ext_vector_type(2)));
typedef float f32x4 __attribute__((ext_vector_type(4)));
typedef short bf16x8 __attribute__((ext_vector_type(8)));
typedef short s16x4 __attribute__((ext_vector_type(4)));

constexpr int NBATCH = 2, SEQ = 8192, M = NBATCH * SEQ, D = 2048, FF = 5632, DH = 256, NH = 4, DR = 1024;
constexpr int NMOD = 18432, INCOLS = 6152, NPROJ = 6144;
constexpr int SC = 256, NSC = SEQ / SC;
constexpr int CROWS = 272;
constexpr float ALPHA = 1.189207115002721f;
constexpr float LN_EPS = 1e-5f;
constexpr size_t MiB = (size_t)1 << 20;
constexpr size_t WS_MOD = 0, WS_BAR = 160 * 1024, WS_ZERO_BYTES = 256 * 1024;
constexpr size_t WS_WGT = 1 * MiB, WS_GATES = 2 * MiB, WS_MDEC = 3 * MiB, WS_QP = 3 * MiB + 256 * 1024, WS_STAT = 7 * MiB  , WS_RGP = 4 * MiB, WS_RGH = 5 * MiB, WS_RGC = 6 * MiB;
constexpr size_t WS_WAT = 8 * MiB, WS_WXT = 8 * MiB + 512 * 1024;
constexpr size_t WS_WOUT = 9 * MiB, WS_WIN = 17 * MiB, WS_W13A = 41 * MiB, WS_W13B = 85 * MiB, WS_W2A = 107 * MiB, WS_W2B = 118 * MiB;
constexpr size_t WS_U = 129 * MiB;
constexpr size_t WS_H = 193 * MiB;
constexpr size_t WS_PROJ = 193 * MiB;
constexpr size_t WS_DC = 385 * MiB;
constexpr size_t WS_CB = 453 * MiB;
constexpr int NKC = 28;
constexpr size_t WS_MODP = 487 * MiB;
constexpr size_t WS_XBH = 492 * MiB;
constexpr size_t WS_END = 556 * MiB;
constexpr int LDS_BYTES = 135168;

struct Params { const float* in[21]; float* out; unsigned char* ws; int wv, pad; };
enum { I_X = 0, I_C, I_WADA, I_BADA, I_F1W13, I_F1W2, I_WIN, I_BIN, I_MNG, I_CONVW, I_CONVB, I_WA, I_BA, I_WX, I_BX, I_LAM, I_WOUT, I_F2W13, I_F2W2, I_LNG, I_LNB };

#define LDS_BARRIER() do { asm volatile("s_waitcnt lgkmcnt(0)" ::: "memory"); __builtin_amdgcn_s_barrier(); asm volatile("" ::: "memory"); } while (0)
#define LDS_WAIT() asm volatile("s_waitcnt lgkmcnt(0)" ::: "memory")
__device__ __forceinline__ unsigned f2bf(float f) { unsigned u = __builtin_bit_cast(unsigned, f); return (u + 0x7fffu + ((u >> 16) & 1u)) >> 16; }
__device__ __forceinline__ unsigned pk2(float lo, float hi) { unsigned r; asm("v_cvt_pk_bf16_f32 %0, %1, %2" : "=v"(r) : "v"(lo), "v"(hi)); return r; }
__device__ __forceinline__ float bflo(unsigned w) { return __builtin_bit_cast(float, w << 16); }
__device__ __forceinline__ float bfhi(unsigned w) { return __builtin_bit_cast(float, w & 0xffff0000u); }
__device__ __forceinline__ float shx(float v, int m, int lane) { return __builtin_bit_cast(float, __builtin_amdgcn_ds_bpermute((lane ^ m) << 2, __builtin_bit_cast(int, v))); }
__device__ __forceinline__ float shup(float v, int d, int lane) { const int s = lane - d; return __builtin_bit_cast(float, __builtin_amdgcn_ds_bpermute((s < 0 ? lane : s) << 2, __builtin_bit_cast(int, v))); }
__device__ __forceinline__ float shfrom(float v, int src) { return __builtin_bit_cast(float, __builtin_amdgcn_ds_bpermute(src << 2, __builtin_bit_cast(int, v))); }
__device__ __forceinline__ float wave_sum(float v, int lane) {
#pragma unroll
    for (int o = 1; o < 64; o <<= 1) v += shx(v, o, lane);
    return v;
}
__device__ __forceinline__ float sigm(float x) { return __builtin_amdgcn_rcpf(1.0f + __builtin_amdgcn_exp2f(-1.4426950408889634f * x)); }
__device__ __forceinline__ float logsigm(float x) { return x < 0.f ? x - log1pf(__expf(x)) : -log1pf(__expf(-x)); }
__device__ __forceinline__ s16x4 tr_read(LAS unsigned char* p) {
    typedef short v4i16_t __attribute__((ext_vector_type(4)));
    return __builtin_bit_cast(s16x4, __builtin_amdgcn_ds_read_tr16_b64_v4i16((LAS v4i16_t*)p));
}
__device__ __forceinline__ bf16x8 cat8(s16x4 lo, s16x4 hi) { return __builtin_shufflevector(lo, hi, 0, 1, 2, 3, 4, 5, 6, 7); }
__device__ __forceinline__ unsigned pk4_fp8(float a, float b, float c, float d) { unsigned w = 0u;
    a = __builtin_amdgcn_fmed3f(a, -448.0f, 448.0f); b = __builtin_amdgcn_fmed3f(b, -448.0f, 448.0f); c = __builtin_amdgcn_fmed3f(c, -448.0f, 448.0f); d = __builtin_amdgcn_fmed3f(d, -448.0f, 448.0f);
    w = __builtin_amdgcn_cvt_pk_fp8_f32(a, b, w, false); w = __builtin_amdgcn_cvt_pk_fp8_f32(c, d, w, true); return w; }
constexpr float FP8_ASCALE = 4.0f, FP8_WSCALE = 64.0f;
constexpr float FP8_HSCALE = 2.0f, FP8_W2SCALE = 128.0f;
constexpr bool UP8_0 = UP8_CFG0, UP8_1 = UP8_CFG1, DN8_0 = DN8_CFG0, DN8_1 = DN8_CFG1;
static_assert(!UP8_0 && UP8_1 && DN8_0 && DN8_1, "the workspace map sizes the weight / H buffers for this fp8 configuration");
#define MFMA16(a, b, c) __builtin_amdgcn_mfma_f32_16x16x32_bf16((a), (b), (c), 0, 0, 0)

#define XB_TMO      128
#define XB_XCNT(j)  (256  + 64 * (j))
#define XB_XSUB(j)  (1280 + 64 * (j))
#define XB_XGEN(j)  (2304 + 64 * (j))
#define XB_TOP      3328
#define XB_TOPGEN   3392
#define XCD_BAR_WORDS 3456
#define XB_SPIN_CAP (1u << 18)

__device__ __forceinline__ unsigned xb_ld(unsigned* p)              { return __hip_atomic_load(p, __ATOMIC_RELAXED, __HIP_MEMORY_SCOPE_AGENT); }
__device__ __forceinline__ unsigned xb_add(unsigned* p, unsigned v) { return __hip_atomic_fetch_add(p, v, __ATOMIC_RELAXED, __HIP_MEMORY_SCOPE_AGENT); }
__device__ __forceinline__ unsigned xb_xcc_id() { return (unsigned)__builtin_amdgcn_s_getreg((3 << 11) | 20) & 0xFu; }
#define XB_SPIN(cond, bar) do { unsigned _sp = 0; while (cond) { __builtin_amdgcn_s_sleep(1); \
    if ((++_sp & 255u) == 0u) { if (xb_ld(&(bar)[XB_TMO])) break; if (_sp > XB_SPIN_CAP) { atomicAdd(&(bar)[XB_TMO], 1u); break; } } } } while (0)

struct XcdBarrier {
    unsigned* bar; unsigned x; int wv;
    volatile LAS unsigned* st;
};

__device__ __forceinline__ XcdBarrier xcd_barrier_post(unsigned* bar, volatile LAS unsigned* st, int wv) {
    XcdBarrier b; b.bar = bar; b.x = xb_xcc_id(); b.st = st; b.wv = wv;
    if (otid(wv) == 0) (void)xb_add(&bar[XB_XCNT(b.x)], 1u);
    return b;
}
__device__ __forceinline__ void xcd_barrier_complete(unsigned* bar, unsigned x, unsigned& nloc, unsigned& nx) {
    const unsigned G = gridDim.x * gridDim.y * gridDim.z;
    unsigned sum, cnt, mine, sp = 0u;
    for (;;) {
        sum = 0u; cnt = 0u; mine = 0u;
#pragma unroll
        for (unsigned j = 0; j < 16; ++j) { const unsigned c = xb_ld(&bar[XB_XCNT(j)]); sum += c; cnt += (c > 0u) ? 1u : 0u; mine = (j == x) ? c : mine; }
        if (sum == G) break;
        __builtin_amdgcn_s_sleep(1);
        if ((++sp & 255u) == 0u) { if (xb_ld(&bar[XB_TMO])) break; if (sp > XB_SPIN_CAP) { atomicAdd(&bar[XB_TMO], 1u); break; } }
    }
    nloc = mine > 0u ? mine : 1u; nx = cnt > 0u ? cnt : 1u;
}

__device__ __forceinline__ void xcd_barrier(const XcdBarrier& b) {
    asm volatile("s_waitcnt vmcnt(0)" ::: "memory");
    __syncthreads();
    if (otid(b.wv) == 0) {
        unsigned* bar = b.bar;
        __builtin_amdgcn_s_waitcnt(0);
        unsigned nloc = b.st[0], nx = b.st[1];
        if (nloc == 0u) { xcd_barrier_complete(bar, b.x, nloc, nx); b.st[0] = nloc; b.st[1] = nx; }
        const unsigned old = xb_add(&bar[XB_XSUB(b.x)], 1u);
        const unsigned gen = old / nloc;
        if (old + 1u == (gen + 1u) * nloc) {
            __builtin_amdgcn_fence(__ATOMIC_RELEASE, "agent");
            asm volatile("s_waitcnt vmcnt(0)" ::: "memory");
            const unsigned og = xb_add(&bar[XB_TOP], 1u);
            const unsigned tg = og / nx;
            if (og + 1u == (tg + 1u) * nx) xb_add(&bar[XB_TOPGEN], 1u);
            else XB_SPIN(xb_ld(&bar[XB_TOPGEN]) == tg, bar);
            __builtin_amdgcn_fence(__ATOMIC_ACQUIRE, "agent");
            xb_add(&bar[XB_XGEN(b.x)], 1u);
            asm volatile("s_waitcnt vmcnt(0)" ::: "memory");
        } else {
            XB_SPIN(xb_ld(&bar[XB_XGEN(b.x)]) == gen, bar);
            __builtin_amdgcn_fence(__ATOMIC_ACQUIRE, "agent");
            asm volatile("s_waitcnt vmcnt(0)" ::: "memory");
        }
    }
    __syncthreads();
}

__device__ __forceinline__ void tr_item(const float* __restrict__ W, int ldw, int K, int src_col, bf16* __restrict__ WT, int dst_row, int k0, LAS float* scr, int lane) {
#pragma unroll 8
    for (int i = 0; i < 32; ++i) { const int kk = 2 * i + (lane >> 5); scr[kk * 33 + (lane & 31)] = __builtin_nontemporal_load(W + (size_t)(k0 + kk) * ldw + src_col + (lane & 31));     }
    LDS_WAIT();
    const int c = lane & 7;
#pragma unroll
    for (int j = 0; j < 4; ++j) { const int n = (lane >> 3) + 8 * j; const LAS float* s = scr + (8 * c) * 33 + n;
        v4u o; o.x = pk2(s[0 * 33], s[1 * 33]); o.y = pk2(s[2 * 33], s[3 * 33]); o.z = pk2(s[4 * 33], s[5 * 33]); o.w = pk2(s[6 * 33], s[7 * 33]);
        *(v4u*)(WT + (size_t)(dst_row + n) * K + k0 + 8 * c) = o; }
    LDS_WAIT();
}
__device__ __forceinline__ void tr_item8(const float* __restrict__ W, int ldw, int K, int src_col, unsigned char* __restrict__ WT, int dst_row, int k0, LAS float* scr, int lane, float wsc) {
#pragma unroll 8
    for (int i = 0; i < 32; ++i) { const int kk = 2 * i + (lane >> 5); scr[kk * 33 + (lane & 31)] = __builtin_nontemporal_load(W + (size_t)(k0 + kk) * ldw + src_col + (lane & 31));     }
    LDS_WAIT();
    const int c = lane & 7;
#pragma unroll
    for (int j = 0; j < 4; ++j) { const int n = (lane >> 3) + 8 * j; const LAS float* s = scr + (8 * c) * 33 + n;
        v2u o; o.x = pk4_fp8(s[0 * 33] * wsc, s[1 * 33] * wsc, s[2 * 33] * wsc, s[3 * 33] * wsc); o.y = pk4_fp8(s[4 * 33] * wsc, s[5 * 33] * wsc, s[6 * 33] * wsc, s[7 * 33] * wsc);
        *(v2u*)(WT + (size_t)(dst_row + n) * K + k0 + 8 * c) = o; }
    LDS_WAIT();
}
__device__ __forceinline__ void p0_prologue(const Params& p, LAS unsigned char* lds) {
    const int tid = otid(p.wv), lane = tid & 63, wave = tid >> 6;
    unsigned char* ws = p.ws;
    LAS float* scr = (LAS float*)(lds + wave * 16384);
    const int gw = blockIdx.x * 8 + wave, NGW = gridDim.x * 8;
    constexpr int I_13 = 32 * 352, I_2 = 88 * 64, I_IN = 32 * 192, I_OUT = 32 * 64, I_RG = 64;
    constexpr int NITEMS = 2 * I_13 + 2 * I_2 + I_IN + I_OUT + 2 * I_RG;
    for (int it = gw; it < NITEMS; it += NGW) {
        int r = it;
        if (r < 2 * I_13) { const int which = r >= I_13; r -= which * I_13; const int kb = r / 352, nb = r % 352, n0 = 32 * nb, pt = n0 >> 8, rr = n0 & 255;
            const int sc = rr < 128 ? 128 * pt + rr : FF + 128 * pt + (rr - 128);
            if (which ? UP8_1 : UP8_0) tr_item8(kin(which ? I_F2W13 : I_F1W13), 2 * FF, D, sc, ws + (which ? WS_W13B : WS_W13A), n0, 64 * kb, scr, lane, FP8_WSCALE);
            else tr_item(kin(which ? I_F2W13 : I_F1W13), 2 * FF, D, sc, (bf16*)(ws + (which ? WS_W13B : WS_W13A)), n0, 64 * kb, scr, lane);
            continue; }
        r -= 2 * I_13;
        if (r < 2 * I_2) { const int which = r >= I_2; r -= which * I_2; const int kb = r >> 6, nb = r & 63;
            if (which ? DN8_1 : DN8_0) tr_item8(kin(which ? I_F2W2 : I_F1W2), D, FF, 32 * nb, ws + (which ? WS_W2B : WS_W2A), 32 * nb, 64 * kb, scr, lane, FP8_W2SCALE);
            else tr_item(kin(which ? I_F2W2 : I_F1W2), D, FF, 32 * nb, (bf16*)(ws + (which ? WS_W2B : WS_W2A)), 32 * nb, 64 * kb, scr, lane);
            continue; }
        r -= 2 * I_2;
        if (r < I_IN) { const int kb = r / 192, nb = r % 192, n0 = 32 * nb;
            tr_item(kin(I_WIN), INCOLS, D, n0 < 4096 ? n0 : n0 + 8, (bf16*)(ws + WS_WIN), n0, 64 * kb, scr, lane); continue; }
        r -= I_IN;
        if (r < I_OUT) { const int kb = r >> 6, nb = r & 63;
            tr_item(kin(I_WOUT), D, D, 32 * nb, (bf16*)(ws + WS_WOUT), 32 * nb, 64 * kb, scr, lane); continue; }
        r -= I_OUT;
        { const int which = r >= I_RG; r -= which * I_RG; const int blk = r >> 3, l = r & 7, kb = l >> 2, nb = l & 3;
            tr_item(kin(which ? I_WX : I_WA) + blk * 16384, 128, 128, 32 * nb, (bf16*)(ws + (which ? WS_WXT : WS_WAT)) + blk * 16384, 32 * nb, 64 * kb, scr, lane); }
    }
    __syncthreads();
    LAS float* sc = (LAS float*)lds;
    for (int i = tid; i < NBATCH * D; i += 512) { const float cv = kin(I_C)[i]; sc[i] = cv / (1.0f + __expf(-cv)); }
    __syncthreads();
    const int gid = blockIdx.x * 512 + tid;
    for (int it = gid; it < NKC * (NMOD / 4); it += gridDim.x * 512) {
        const int cgp = it % (NMOD / 4), kc = it / (NMOD / 4);
        const int k0 = 73 * kc + (kc < 4 ? kc : 4), klen = 73 + (kc < 4 ? 1 : 0);
        const f32x4* wp = (const f32x4*)(kin(I_WADA) + (size_t)k0 * NMOD) + cgp;
        f32x4 a0 = {0.f, 0.f, 0.f, 0.f}, a1 = {0.f, 0.f, 0.f, 0.f};
#pragma unroll 8
        for (int k = 0; k < klen; ++k) { const f32x4 w = __builtin_nontemporal_load(wp + (size_t)k * (NMOD / 4)); a0 += w * sc[k0 + k]; a1 += w * sc[D + k0 + k]; }
        if (kc == 0) { const f32x4 b4 = ((const f32x4*)kin(I_BADA))[cgp]; a0 += b4; a1 += b4; }
        f32x4* mp = (f32x4*)(ws + WS_MODP) + (size_t)kc * (2 * NMOD / 4) + cgp; mp[0] = a0; mp[NMOD / 4] = a1;
    }
    for (int it = gid; it < 8 * D; it += gridDim.x * 512) { const int g = it >> 11, k = it & 2047; ((float*)(ws + WS_WGT))[it] = kin(I_WIN)[(size_t)k * INCOLS + 4096 + g]; }
    __syncthreads();
}

constexpr int L_RP_G = 0, L_RP_B = 8192, L_RP_SC = 16384, L_RP_SH = 24576, L_RP_W = 32768, L_RP_GT = 98304;
__device__ __forceinline__ void row_pass(const Params& p, const void* src, bool src16  , float* dstx, int ln_idx  , int mod_idx  , bool do_gates, bool fp8out, bool from_partials, bool write_x, LAS unsigned char* lds) {
    const int tid = otid(p.wv), lane = tid & 63, wave = tid >> 6;
    const float* mod = (const float*)(p.ws + WS_MOD);
    bf16* U = (bf16*)(p.ws + WS_U);
    int r0, r1;
    if (gridDim.x == 256) { const int xcd = blockIdx.x & 7, idx = blockIdx.x >> 3; r0 = (8 * xcd + (idx >> 2)) * 256 + (idx & 3) * 64; r1 = r0 + 64; }
    else { r0 = (int)(((long)blockIdx.x * M) / gridDim.x); r1 = (int)(((long)(blockIdx.x + 1) * M) / gridDim.x); }
    LAS f32x4* Lg = (LAS f32x4*)(lds + L_RP_G); LAS f32x4* Lb = (LAS f32x4*)(lds + L_RP_B); LAS f32x4* Lsc = (LAS f32x4*)(lds + L_RP_SC); LAS f32x4* Lsh = (LAS f32x4*)(lds + L_RP_SH);
    LAS f32x4* Lw = (LAS f32x4*)(lds + L_RP_W);
    if (from_partials) {
        float* modw = (float*)(p.ws + WS_MOD); const float* pp = (const float*)(p.ws + WS_MODP);
        for (int i = blockIdx.x * 512 + tid; i < 2 * NMOD; i += gridDim.x * 512) { float s = 0.f;
#pragma unroll 4
            for (int kc = 0; kc < NKC; ++kc) s += pp[(size_t)kc * (2 * NMOD) + i];
            modw[i] = s; }
    }
    for (int b = 0; b < NBATCH; ++b) {
        const int s0 = r0 > b * SEQ ? r0 : b * SEQ, s1 = r1 < (b + 1) * SEQ ? r1 : (b + 1) * SEQ;
        if (s0 >= s1) continue;
        __syncthreads();
        if (ln_idx >= 0) { Lg[tid] = ((const f32x4*)(kin(I_LNG) + ln_idx * D))[tid]; Lb[tid] = ((const f32x4*)(kin(I_LNB) + ln_idx * D))[tid]; }
        if (mod_idx >= 0) {
            if (from_partials) { const f32x4* pp = (const f32x4*)(p.ws + WS_MODP) + ((size_t)b * NMOD + mod_idx * 3 * D) / 4 + tid; f32x4 sh = {0.f, 0.f, 0.f, 0.f}, sc = {0.f, 0.f, 0.f, 0.f};
#pragma unroll 4
                for (int kc = 0; kc < NKC; ++kc) { sh += pp[(size_t)kc * (2 * NMOD / 4)]; sc += pp[(size_t)kc * (2 * NMOD / 4) + D / 4]; }
                Lsh[tid] = sh; Lsc[tid] = sc + 1.0f;
            } else { const f32x4* mp = (const f32x4*)(mod + (size_t)b * NMOD + mod_idx * 3 * D); Lsh[tid] = mp[tid]; Lsc[tid] = mp[D / 4 + tid] + 1.0f; } }
        if (do_gates) { const f32x4* wg = (const f32x4*)(p.ws + WS_WGT);
#pragma unroll
            for (int g = 0; g < 8; ++g) Lw[g * 512 + tid] = wg[g * 512 + tid]; }
        __syncthreads();
        int m = s0 + wave;
        typedef _Float16 f16x4 __attribute__((ext_vector_type(4)));
        f32x4 nx[8]; f16x4 nh[8];
        const bool last_use = (mod_idx < 0);
#define RP_LOAD(row_) do { if (src16) { const f16x4* xr_ = (const f16x4*)((const bf16*)src + (size_t)(row_) * D) + lane; \
            if (last_use) { _Pragma("unroll") for (int j = 0; j < 8; ++j) nh[j] = __builtin_nontemporal_load(xr_ + 64 * j); } \
            else { _Pragma("unroll") for (int j = 0; j < 8; ++j) nh[j] = xr_[64 * j]; } } \
        else { const f32x4* xr_ = (const f32x4*)((const float*)src + (size_t)(row_) * D) + lane; _Pragma("unroll") for (int j = 0; j < 8; ++j) nx[j] = xr_[64 * j]; } } while (0)
        if (m < s1) RP_LOAD(m);
        for (; m < s1; m += 8) {
            f32x4 v[8]; f32x4 s4 = {0.f, 0.f, 0.f, 0.f};
#pragma unroll
            for (int j = 0; j < 8; ++j) { v[j] = src16 ? __builtin_convertvector(nh[j], f32x4) : nx[j]; s4 += v[j]; }
            if (m + 8 < s1) RP_LOAD(m + 8);
            float mean = wave_sum((s4.x + s4.y) + (s4.z + s4.w), lane) * (1.f / D); f32x4 q4 = {0.f, 0.f, 0.f, 0.f};
#pragma unroll
            for (int j = 0; j < 8; ++j) { v[j] = v[j] - mean; q4 += v[j] * v[j]; }
            float rstd = 1.0f / sqrtf(wave_sum((q4.x + q4.y) + (q4.z + q4.w), lane) * (1.f / D) + LN_EPS);
            if (ln_idx >= 0) {
                f32x4* xo = (f32x4*)(dstx + (size_t)m * D) + lane; s4 = (f32x4){0.f, 0.f, 0.f, 0.f};
#pragma unroll
                for (int j = 0; j < 8; ++j) { v[j] = (v[j] * rstd) * Lg[lane + 64 * j] + Lb[lane + 64 * j]; if (write_x) { if (last_use) __builtin_nontemporal_store(v[j], xo + 64 * j); else xo[64 * j] = v[j]; } s4 += v[j]; }
                if (!write_x && lane == 0) { float* st = (float*)(p.ws + WS_STAT) + 2 * (size_t)m; st[0] = mean; st[1] = rstd; }
                if (mod_idx < 0) continue;
                mean = wave_sum((s4.x + s4.y) + (s4.z + s4.w), lane) * (1.f / D); q4 = (f32x4){0.f, 0.f, 0.f, 0.f};
#pragma unroll
                for (int j = 0; j < 8; ++j) { v[j] = v[j] - mean; q4 += v[j] * v[j]; }
                rstd = 1.0f / sqrtf(wave_sum((q4.x + q4.y) + (q4.z + q4.w), lane) * (1.f / D) + LN_EPS);
            }
            if (fp8out) { unsigned* uo8 = (unsigned*)((unsigned char*)U + (size_t)m * D) + lane;
                const float rs = rstd * FP8_ASCALE;
#pragma unroll
                for (int j = 0; j < 8; ++j) { v[j] = (v[j] * rs) * Lsc[lane + 64 * j] + Lsh[lane + 64 * j] * FP8_ASCALE; uo8[64 * j] = pk4_fp8(v[j].x, v[j].y, v[j].z, v[j].w); }
            } else { v2u* uo = (v2u*)(U + (size_t)m * D) + lane;
#pragma unroll
                for (int j = 0; j < 8; ++j) { v[j] = (v[j] * rstd) * Lsc[lane + 64 * j] + Lsh[lane + 64 * j]; v2u w; w.x = pk2(v[j].x, v[j].y); w.y = pk2(v[j].z, v[j].w); uo[64 * j] = w; } }
            if (do_gates) {
                float d[8];
#pragma unroll
                for (int g = 0; g < 8; ++g) { f32x4 d4 = {0.f, 0.f, 0.f, 0.f};
#pragma unroll
                    for (int j = 0; j < 8; ++j) d4 += v[j] * Lw[g * 512 + lane + 64 * j];
                    d[g] = (d4.x + d4.y) + (d4.z + d4.w);
                    asm volatile("" ::: "memory"); }
                float e4[4], e2[2], e1;
                const bool h32 = lane & 32, h16 = lane & 16, h8 = lane & 8;
#pragma unroll
                for (int k = 0; k < 4; ++k) { const float keep = h32 ? d[k + 4] : d[k], send = h32 ? d[k] : d[k + 4]; e4[k] = keep + shx(send, 32, lane); }
#pragma unroll
                for (int k = 0; k < 2; ++k) { const float keep = h16 ? e4[k + 2] : e4[k], send = h16 ? e4[k] : e4[k + 2]; e2[k] = keep + shx(send, 16, lane); }
                { const float keep = h8 ? e2[1] : e2[0], send = h8 ? e2[0] : e2[1]; e1 = keep + shx(send, 8, lane); }
                e1 += shx(e1, 4, lane); e1 += shx(e1, 2, lane); e1 += shx(e1, 1, lane);
                if ((lane & 7) == 0) { const int g = (lane >> 3); const float gv = e1 + kin(I_BIN)[4096 + g]; ((float*)(p.ws + WS_GATES))[(size_t)m * 8 + g] = gv; ((LAS float*)(lds + L_RP_GT))[((m - s0) & 63) * 8 + g] = gv; }
            }
        }
        if (do_gates) {
            __syncthreads();
            if (tid < NH) { const LAS float* gt = (const LAS float*)(lds + L_RP_GT); float A = 0.f, B = -__builtin_inff();
                for (int t = 0; t < 64; ++t) { const float li = gt[t * 8 + tid], lf = logsigm(gt[t * 8 + 4 + tid]); B = fmaxf(B + lf, li); A += lf; }
                float* qp = (float*)(p.ws + WS_QP) + ((size_t)(s0 >> 6) * NH + tid) * 2; qp[0] = A; qp[1] = B; }
        }
    }
    __syncthreads();
}
constexpr int KV_BUF = 34816;
constexpr int KT_PITCH = 528, VT_PITCH = 560, KV_VOFF = 16896;
constexpr int CT_BUF = 50688;
constexpr int L_GB = 104448, L_GLI = L_GB + 1024, L_GM = L_GB + 2048, L_GW = L_GB + 3072, L_MISC = L_GB + 4096;

__device__ __forceinline__ void mlstm_gates(const float* __restrict__ gates, const float* __restrict__ qp, int b, int h, int j, LAS unsigned char* lds, int wv) {
    const int tid = otid(wv), lane = tid & 63, wave = tid >> 6;
    LAS float* GB = (LAS float*)(lds + L_GB); LAS float* GLI = (LAS float*)(lds + L_GLI); LAS float* GM = (LAS float*)(lds + L_GM); LAS float* MISC = (LAS float*)(lds + L_MISC);
    const float NEG = -__builtin_inff();
    if (wave == 0) {
        float A = 0.f, B = NEG;
#pragma unroll
        for (int i = 0; i < 2; ++i) { const int qi = 2 * lane + i; if (qi < 4 * j) { const float a = qp[((size_t)(b * 128 + qi) * NH + h) * 2], bb = qp[((size_t)(b * 128 + qi) * NH + h) * 2 + 1]; B = fmaxf(B + a, bb); A += a; } }
#pragma unroll
        for (int o = 1; o < 64; o <<= 1) { const float Ap = shup(A, o, lane), Bp = shup(B, o, lane); if (lane >= o) { B = fmaxf(Bp + A, B); A = Ap + A; } }
        const float mend = fmaxf(A, B);
        float ms = shfrom(mend, (2 * j - 1) & 63); if (j == 0) ms = 0.f;
        const float* gp = gates + ((size_t)b * SEQ + SC * j + 4 * lane) * 8;
        float li[4], lf[4], cs[4];
#pragma unroll
        for (int i = 0; i < 4; ++i) { li[i] = gp[i * 8 + h]; lf[i] = logsigm(gp[i * 8 + 4 + h]); }
        cs[0] = lf[0]; cs[1] = cs[0] + lf[1]; cs[2] = cs[1] + lf[2]; cs[3] = cs[2] + lf[3];
        float incl = cs[3];
#pragma unroll
        for (int o = 1; o < 64; o <<= 1) { const float t = shup(incl, o, lane); if (lane >= o) incl += t; }
        const float excl = incl - cs[3];
        float LA = cs[3], LB = NEG;
#pragma unroll
        for (int i = 0; i < 4; ++i) LB = fmaxf(LB + lf[i], li[i]);
#pragma unroll
        for (int o = 1; o < 64; o <<= 1) { const float Ap = shup(LA, o, lane), Bp = shup(LB, o, lane); if (lane >= o) { LB = fmaxf(Bp + LA, LB); LA = Ap + LA; } }
        const float Ae = shup(LA, 1, lane), Be = shup(LB, 1, lane);
        float mp = (lane == 0) ? ms : fmaxf(ms + Ae, Be);
#pragma unroll
        for (int i = 0; i < 4; ++i) { mp = fmaxf(mp + lf[i], li[i]); GB[4 * lane + i] = excl + cs[i]; GLI[4 * lane + i] = li[i]; GM[4 * lane + i] = mp; }
        if (lane == 0) MISC[0] = ms;
    }
    LDS_BARRIER();
}
#define KV_LOAD(blk) do { int t_ = tid; asm volatile("" : "+v"(t_)); _Pragma("unroll") for (int i_ = 0; i_ < 2; ++i_) { const int c_ = t_ + 512 * i_, r_ = c_ >> 5, ch_ = c_ & 31; \
        rk[i_] = *(const v4u*)(Kp + (size_t)(32 * (blk) + r_) * DR + 8 * ch_); rv[i_] = *(const v4u*)(Vp + (size_t)(32 * (blk) + r_) * DR + 8 * ch_); } } while (0)
#define KV_STORE(buf) do { int t_ = tid; asm volatile("" : "+v"(t_)); _Pragma("unroll") for (int i_ = 0; i_ < 2; ++i_) { const int c_ = t_ + 512 * i_, r_ = c_ >> 5, ch_ = c_ & 31; \
        *(LAS v4u*)(lds + (buf) * KV_BUF + r_ * KT_PITCH + 16 * ch_) = rk[i_]; *(LAS v4u*)(lds + (buf) * KV_BUF + KV_VOFF + r_ * VT_PITCH + 16 * ch_) = rv[i_]; } } while (0)
__device__ __forceinline__ void preset_ones_col(LAS unsigned char* lds, int tid) {
    if (tid < 128) { const int bf = tid >> 6, r = (tid >> 1) & 31, hf = tid & 1; v4u z = {0u, 0u, 0u, 0u}; if (!hf) z.x = 0x3F80u; *(LAS v4u*)(lds + bf * KV_BUF + KV_VOFF + r * VT_PITCH + 512 + 16 * hf) = z; }
}
__device__ __forceinline__ bf16x8 scale8(bf16x8 x, f32x4 wl, f32x4 wh) {
    const v4u u = __builtin_bit_cast(v4u, x); v4u o;
    o.x = pk2(bflo(u.x) * wl.x, bfhi(u.x) * wl.y); o.y = pk2(bflo(u.y) * wl.z, bfhi(u.y) * wl.w); o.z = pk2(bflo(u.z) * wh.x, bfhi(u.z) * wh.y); o.w = pk2(bflo(u.w) * wh.z, bfhi(u.w) * wh.w);
    return __builtin_bit_cast(bf16x8, o);
}
__device__ __forceinline__ void m1_unit(const Params& p, int bh, int j, LAS unsigned char* lds) {
    const int tid = otid(p.wv), lane = tid & 63, wave = tid >> 6, b = bh >> 2, h = bh & 3;
    LAS float* GB = (LAS float*)(lds + L_GB); LAS float* GLI = (LAS float*)(lds + L_GLI); LAS float* GM = (LAS float*)(lds + L_GM); LAS float* GW = (LAS float*)(lds + L_GW);
    LAS float* MISC = (LAS float*)(lds + L_MISC);
    const bf16* Kp = (const bf16*)(p.ws + WS_PROJ) + (size_t)1 * M * DR + ((size_t)b * SEQ + SC * j) * DR + h * DH;
    const bf16* Vp = (const bf16*)(p.ws + WS_PROJ) + (size_t)2 * M * DR + ((size_t)b * SEQ + SC * j) * DR + h * DH;
    v4u rk[2], rv[2];
    KV_LOAD(0);
    mlstm_gates((const float*)(p.ws + WS_GATES), (const float*)(p.ws + WS_QP), b, h, j, lds, p.wv);
    const float b_last = GB[SC - 1], m_end = GM[SC - 1], m_start = MISC[0];
    if (tid < SC) GW[tid] = __expf(b_last - GB[tid] + GLI[tid] - m_end) * 0.0625f;
    if (tid == 0) ((float*)(p.ws + WS_MDEC))[bh * NSC + j] = __expf(b_last + m_start - m_end);
    preset_ones_col(lds, tid);
    KV_STORE(0); KV_LOAD(1);
    LDS_BARRIER();
    f32x4 acc[17][2];
#pragma unroll
    for (int mt = 0; mt < 17; ++mt) { acc[mt][0] = (f32x4){0.f, 0.f, 0.f, 0.f}; acc[mt][1] = (f32x4){0.f, 0.f, 0.f, 0.f}; }
#pragma unroll 1
    for (int sb = 0; sb < 8; ++sb) {
        int g = lane >> 4, q = (lane & 15) >> 2, pp = lane & 3; asm volatile("" : "+v"(g), "+v"(q), "+v"(pp));
        LAS unsigned char* buf = lds + (sb & 1) * KV_BUF;
        {
            const int rowoff = 8 * g + q;
            LAS unsigned char* kb = buf + rowoff * KT_PITCH + (32 * wave + 4 * pp) * 2;
            const f32x4 wl = *(const LAS f32x4*)(GW + 32 * sb + 8 * g), wh = *(const LAS f32x4*)(GW + 32 * sb + 8 * g + 4);
            const bf16x8 b0 = scale8(cat8(tr_read(kb), tr_read(kb + 4 * KT_PITCH)), wl, wh), b1 = scale8(cat8(tr_read(kb + 32), tr_read(kb + 32 + 4 * KT_PITCH)), wl, wh);
            LAS unsigned char* vb = buf + KV_VOFF + rowoff * VT_PITCH + (4 * pp) * 2;
#pragma unroll
            for (int mt = 0; mt < 17; ++mt) { const bf16x8 a = cat8(tr_read(vb + 32 * mt), tr_read(vb + 32 * mt + 4 * VT_PITCH));
                acc[mt][0] = MFMA16(a, b0, acc[mt][0]); acc[mt][1] = MFMA16(a, b1, acc[mt][1]); if ((mt & 3) == 3) asm volatile("" ::: "memory"); }
        }
        if (sb + 1 < 8) KV_STORE((sb + 1) & 1);
        if (sb + 2 < 8) KV_LOAD(sb + 2);
        LDS_BARRIER();
    }
    float* dc = (float*)(p.ws + WS_DC) + (size_t)(bh * NSC + j) * CROWS * DH;
#pragma unroll
    for (int mt = 0; mt < 17; ++mt) {
        int ro = (4 * (lane >> 4)) * DH + 32 * wave + (lane & 15); asm volatile("" : "+v"(ro));
        float* dp = dc + (size_t)(16 * mt) * DH + ro;
#pragma unroll
        for (int nl = 0; nl < 2; ++nl)
#pragma unroll
            for (int i = 0; i < 4; ++i) dp[i * DH + 16 * nl] = acc[mt][nl][i]; }
}
__device__ __forceinline__ void m2_scan(const Params& p) {
    const float* __restrict__ dc = (const float*)(p.ws + WS_DC); bf16* __restrict__ cb = (bf16*)(p.ws + WS_CB); const float* __restrict__ dec = (const float*)(p.ws + WS_MDEC);
    constexpr int PER = CROWS * DH / 4;
    const int nthr = gridDim.x * 512;
    for (int it = blockIdx.x * 512 + otid(p.wv); it < 8 * PER; it += 2 * nthr) {
        const bool two = it + nthr < 8 * PER; const int it1 = two ? it + nthr : it;
        const int bh0 = it / PER, idx0 = it % PER, bh1 = it1 / PER, idx1 = it1 % PER;
        const f32x4* src0 = (const f32x4*)(dc + (size_t)bh0 * NSC * CROWS * DH) + idx0; v2u* dst0 = (v2u*)(cb + (size_t)bh0 * NSC * CROWS * DH) + idx0;
        const f32x4* src1 = (const f32x4*)(dc + (size_t)bh1 * NSC * CROWS * DH) + idx1; v2u* dst1 = (v2u*)(cb + (size_t)bh1 * NSC * CROWS * DH) + idx1;
        f32x4 C0 = {0.f, 0.f, 0.f, 0.f}, C1 = {0.f, 0.f, 0.f, 0.f};
#pragma unroll 8
        for (int j = 0; j < NSC; ++j) {
            const f32x4 d0 = __builtin_nontemporal_load(src0 + (size_t)j * PER), d1 = __builtin_nontemporal_load(src1 + (size_t)j * PER);
            v2u w; w.x = pk2(C0.x, C0.y); w.y = pk2(C0.z, C0.w); dst0[(size_t)j * PER] = w;
            if (two) { v2u w1; w1.x = pk2(C1.x, C1.y); w1.y = pk2(C1.z, C1.w); dst1[(size_t)j * PER] = w1; }
            C0 = C0 * dec[bh0 * NSC + j] + d0; C1 = C1 * dec[bh1 * NSC + j] + d1; }
    }
}
#define CT_LOAD(row0, npc) do { int t_ = tid; asm volatile("" : "+v"(t_)); _Pragma("unroll") for (int i_ = 0; i_ < (npc); ++i_) rc[i_] = *(const v4u*)(cb + (size_t)(row0) * DH + (size_t)(t_ + 512 * i_) * 8); } while (0)
#define CT_STORE(buf, npc) do { int t_ = tid; asm volatile("" : "+v"(t_)); _Pragma("unroll") for (int i_ = 0; i_ < (npc); ++i_) { const int c_ = t_ + 512 * i_, r_ = c_ >> 5, ch_ = c_ & 31; *(LAS v4u*)(lds + (buf) * CT_BUF + r_ * KT_PITCH + 16 * ch_) = rc[i_]; } } while (0)
#define CT_MMA(buf, MT0, MT1) do { _Pragma("unroll") for (int mt = (MT0); mt < (MT1); ++mt) { \
        LAS unsigned char* ap_ = lds + (buf) * CT_BUF + (16 * (mt - (MT0)) + l15) * KT_PITCH + 16 * g; \
        _Pragma("unroll") for (int ks = 0; ks < 8; ++ks) acc[mt] = MFMA16(*(const LAS bf16x8*)(ap_ + 64 * ks), bq[ks], acc[mt]); \
        if ((mt - (MT0)) & 1) asm volatile("" ::: "memory"); } } while (0)
__device__ __forceinline__ void m3_unit(const Params& p, int bh, int j, LAS unsigned char* lds) {
    const int tid = otid(p.wv), lane = tid & 63, wave = tid >> 6, b = bh >> 2, h = bh & 3;
    LAS float* GB = (LAS float*)(lds + L_GB); LAS float* GLI = (LAS float*)(lds + L_GLI); LAS float* GM = (LAS float*)(lds + L_GM); LAS float* MISC = (LAS float*)(lds + L_MISC);
    const size_t tokbase = (size_t)b * SEQ + SC * j;
    const bf16* Qp = (const bf16*)(p.ws + WS_PROJ) + tokbase * DR + h * DH;
    const bf16* Kp = (const bf16*)(p.ws + WS_PROJ) + (size_t)1 * M * DR + tokbase * DR + h * DH;
    const bf16* Vp = (const bf16*)(p.ws + WS_PROJ) + (size_t)2 * M * DR + tokbase * DR + h * DH;
    const bf16* Op = (const bf16*)(p.ws + WS_PROJ) + (size_t)3 * M * DR + tokbase * DR + h * DH;
    const bf16* cb = (const bf16*)(p.ws + WS_CB) + (size_t)(bh * NSC + j) * CROWS * DH;
    bf16* Y = (bf16*)(p.ws + WS_U) + tokbase * D + h * DH;
    const float* ng = kin(I_MNG) + h * DH;
    v4u rc[6];
    CT_LOAD(0, 6);
    mlstm_gates((const float*)(p.ws + WS_GATES), (const float*)(p.ws + WS_QP), b, h, j, lds, p.wv);
    const float m_start = MISC[0];
#pragma unroll 1
    for (int ps = 0; ps < 2; ++ps) {
        int l15 = lane & 15, g = lane >> 4, pp = lane & 3; asm volatile("" : "+v"(l15), "+v"(g), "+v"(pp));
        const int q = l15 >> 2;
        const int t0 = 128 * ps + 16 * wave, tl = t0 + l15;
        bf16x8 bq[8];
#pragma unroll
        for (int ks = 0; ks < 8; ++ks) bq[ks] = *(const bf16x8*)(Qp + (size_t)tl * DR + 32 * ks + 8 * g);
        f32x4 acc[17];
#pragma unroll
        for (int mt = 0; mt < 17; ++mt) acc[mt] = (f32x4){0.f, 0.f, 0.f, 0.f};
        CT_STORE(0, 6); CT_LOAD(96, 6);
        LDS_BARRIER();
        CT_MMA(0, 0, 6);
        CT_STORE(1, 6); CT_LOAD(192, 5);
        LDS_BARRIER();
        CT_MMA(1, 6, 12);
        CT_STORE(0, 5);
        LDS_BARRIER();
        CT_MMA(0, 12, 17);
        v4u rk[2], rv[2];
        KV_LOAD(0);
        const float bt = GB[tl], mt_ = GM[tl];
        const float winter = __expf(bt + m_start - mt_);
#pragma unroll
        for (int mt = 0; mt < 17; ++mt) acc[mt] = acc[mt] * winter;
        LDS_BARRIER();
        const int nblk = 4 * ps + 4;
        preset_ones_col(lds, tid);
        KV_STORE(0); KV_LOAD(1);
        LDS_BARRIER();
#pragma unroll 1
        for (int kb = 0; kb < nblk; ++kb) {
            const int s0 = 32 * kb;
            if (s0 <= t0 + 15) {
                LAS unsigned char* buf = lds + (kb & 1) * KV_BUF;
                f32x4 sa = {0.f, 0.f, 0.f, 0.f}, sb = {0.f, 0.f, 0.f, 0.f};
                LAS unsigned char* kr = buf + l15 * KT_PITCH + 16 * g;
#pragma unroll
                for (int ks = 0; ks < 8; ++ks) { const bf16x8 ka = *(const LAS bf16x8*)(kr + 64 * ks), kb2 = *(const LAS bf16x8*)(kr + 16 * KT_PITCH + 64 * ks);
                    sa = MFMA16(ka, bq[ks], sa); sb = MFMA16(kb2, bq[ks], sb); }
                float pa[4], pb[4];
#pragma unroll
                for (int i = 0; i < 4; ++i) { const int s1 = s0 + 4 * g + i, s2 = s1 + 16;
                    const float w1 = (s1 <= tl) ? __expf(bt - GB[s1] + GLI[s1] - mt_) * 0.0625f : 0.f;
                    const float w2 = (s2 <= tl) ? __expf(bt - GB[s2] + GLI[s2] - mt_) * 0.0625f : 0.f;
                    pa[i] = sa[i] * w1; pb[i] = sb[i] * w2; }
                v4u pw; pw.x = pk2(pa[0], pa[1]); pw.y = pk2(pa[2], pa[3]); pw.z = pk2(pb[0], pb[1]); pw.w = pk2(pb[2], pb[3]);
                const bf16x8 pf = __builtin_bit_cast(bf16x8, pw);
                LAS unsigned char* vb = buf + KV_VOFF + (4 * g + q) * VT_PITCH + (4 * pp) * 2;
#pragma unroll
                for (int mt = 0; mt < 17; ++mt) { const bf16x8 a = cat8(tr_read(vb + 32 * mt), tr_read(vb + 32 * mt + 16 * VT_PITCH)); acc[mt] = MFMA16(a, pf, acc[mt]); if ((mt & 3) == 3) asm volatile("" ::: "memory"); }
            }
            if (kb + 1 < nblk) KV_STORE((kb + 1) & 1);
            if (kb + 2 < nblk) KV_LOAD(kb + 2);
            LDS_BARRIER();
        }
        if (ps == 0) CT_LOAD(0, 6);
        const float den = shfrom(acc[16][0], l15);
        const float inv = 1.0f / fmaxf(fabsf(den), __expf(-mt_));
        float s = 0.f;
#pragma unroll
        for (int mt = 0; mt < 16; ++mt) { acc[mt] = acc[mt] * inv; s += (acc[mt][0] + acc[mt][1]) + (acc[mt][2] + acc[mt][3]); }
        s += shx(s, 16, lane); s += shx(s, 32, lane);
        const float mean = s * (1.f / DH); float s2 = 0.f;
#pragma unroll
        for (int mt = 0; mt < 16; ++mt) { acc[mt] = acc[mt] - mean; s2 += (acc[mt][0] * acc[mt][0] + acc[mt][1] * acc[mt][1]) + (acc[mt][2] * acc[mt][2] + acc[mt][3] * acc[mt][3]); }
        s2 += shx(s2, 16, lane); s2 += shx(s2, 32, lane);
        const float rstd = 1.0f / sqrtf(s2 * (1.f / DH) + LN_EPS);
#pragma unroll
        for (int mt = 0; mt < 16; ++mt) { const int e = 16 * mt + 4 * g;
            const f32x4 g4 = *(const f32x4*)(ng + e); const v2u o2 = *(const v2u*)(Op + (size_t)tl * DR + e);
            const float y0 = acc[mt][0] * rstd * g4.x * sigm(bflo(o2.x)), y1 = acc[mt][1] * rstd * g4.y * sigm(bfhi(o2.x));
            const float y2 = acc[mt][2] * rstd * g4.z * sigm(bflo(o2.y)), y3 = acc[mt][3] * rstd * g4.w * sigm(bfhi(o2.y));
            v2u w; w.x = pk2(y0, y1); w.y = pk2(y2, y3); *(v2u*)(Y + (size_t)tl * D + e) = w; }
    }
    LDS_BARRIER();
}

constexpr int RG_XC = 0, XC_PITCH = 272, XC_BUF = 17408;
constexpr int RG_CW = 34816;
constexpr int RG_HS = 37888, HS_PITCH = 132;
__device__ __forceinline__ float gelu_tanh(float x) { return x * sigm(x * (1.5957691216057308f + 0.07135481283f * x * x)); }
#define RG_LOADX(tile_) do { const int tok_ = (tile_) * 64 + tt, tsq_ = tok_ & (SEQ - 1); _Pragma("unroll") for (int tap = 0; tap < 4; ++tap) { \
        const int row_ = (tsq_ - 3 + tap >= 0) ? tok_ - 3 + tap : tok_; const bf16* xp_ = XR + (size_t)row_ * DR + blk * 128 + 16 * c8; xr[tap][0] = *(const v4u*)xp_; xr[tap][1] = *(const v4u*)(xp_ + 8); } } while (0)
__device__ __forceinline__ void rg_phase(const Params& p, int pass, LAS unsigned char* lds) {
    const int tid = otid(p.wv), lane = tid & 63, wave = tid >> 6, g = lane >> 4, l15 = lane & 15;
    const bf16* XR = (const bf16*)(p.ws + WS_PROJ) + (size_t)4 * M * DR; const bf16* GR = (const bf16*)(p.ws + WS_PROJ) + (size_t)5 * M * DR;
    const int blk = blockIdx.x & 7, tstep = gridDim.x >> 3, tt = tid >> 3, c8 = tid & 7;
    LAS float* CW = (LAS float*)(lds + RG_CW); LAS float* HS = (LAS float*)(lds + RG_HS);
    { const int tap = tid >> 7, c = tid & 127; CW[tid] = kin(I_CONVW)[tap * DR + blk * 128 + c]; if (tid < 128) CW[512 + tid] = kin(I_CONVB)[blk * 128 + tid]; }
    bf16x8 fa[4], fx[4];
    { const bf16* wa = (const bf16*)(p.ws + WS_WAT) + blk * 16384 + (16 * wave + l15) * 128 + 8 * g;
      const bf16* wx = (const bf16*)(p.ws + WS_WXT) + blk * 16384 + (16 * wave + l15) * 128 + 8 * g;
#pragma unroll
      for (int ks = 0; ks < 4; ++ks) { fa[ks] = *(const bf16x8*)(wa + 32 * ks); fx[ks] = *(const bf16x8*)(wx + 32 * ks); } }
    const int c = 16 * wave + l15, ch = blk * 128 + c;
    const float bav = kin(I_BA)[ch], bxv = kin(I_BX)[ch], sp8 = 8.0f * log1pf(__expf(-kin(I_LAM)[ch]));
    v4u xr[4][2], gq[2];
    int tile = blockIdx.x >> 3;
    if (tile < M / 64) RG_LOADX(tile);
    LDS_BARRIER();
#pragma unroll 1
    for (int it = 0; tile < M / 64; tile += tstep, ++it) {
        const int tok = tile * 64 + tt, tseq = tok & (SEQ - 1);
        LAS unsigned char* xc = lds + RG_XC + (it & 1) * XC_BUF;
#pragma unroll
        for (int hf = 0; hf < 2; ++hf) { float a[8];
            { const f32x4 b0 = *(const LAS f32x4*)(CW + 512 + 16 * c8 + 8 * hf), b1 = *(const LAS f32x4*)(CW + 512 + 16 * c8 + 8 * hf + 4); a[0] = b0.x; a[1] = b0.y; a[2] = b0.z; a[3] = b0.w; a[4] = b1.x; a[5] = b1.y; a[6] = b1.z; a[7] = b1.w; }
#pragma unroll
            for (int tap = 0; tap < 4; ++tap) { const float vm = (tseq - 3 + tap >= 0) ? 1.0f : 0.0f; const v4u x = xr[tap][hf];
                const f32x4 w0 = *(const LAS f32x4*)(CW + tap * 128 + 16 * c8 + 8 * hf) * vm, w1 = *(const LAS f32x4*)(CW + tap * 128 + 16 * c8 + 8 * hf + 4) * vm;
                a[0] += bflo(x.x) * w0.x; a[1] += bfhi(x.x) * w0.y; a[2] += bflo(x.y) * w0.z; a[3] += bfhi(x.y) * w0.w;
                a[4] += bflo(x.z) * w1.x; a[5] += bfhi(x.z) * w1.y; a[6] += bflo(x.w) * w1.z; a[7] += bfhi(x.w) * w1.w; }
            v4u o; o.x = pk2(a[0], a[1]); o.y = pk2(a[2], a[3]); o.z = pk2(a[4], a[5]); o.w = pk2(a[6], a[7]);
            *(LAS v4u*)(xc + tt * XC_PITCH + (16 * c8 + 8 * hf) * 2) = o; }
        float carry = (pass == 1) ? ((const float*)(p.ws + WS_RGC))[(size_t)tile * DR + ch] : 0.f;
        if (pass == 1) { const bf16* gp = GR + (size_t)tok * DR + blk * 128 + 16 * c8; gq[0] = *(const v4u*)gp; gq[1] = *(const v4u*)(gp + 8); }
        asm volatile("" ::: "memory");
        { const int nt_ = (tile + tstep < M / 64) ? tile + tstep : tile; RG_LOADX(nt_); }
        LDS_BARRIER();
        f32x4 ar[4], ai[4];
#pragma unroll
        for (int mt = 0; mt < 4; ++mt) { ar[mt] = (f32x4){0.f, 0.f, 0.f, 0.f}; ai[mt] = (f32x4){0.f, 0.f, 0.f, 0.f};
#pragma unroll
            for (int ks = 0; ks < 4; ++ks) { const bf16x8 a = *(const LAS bf16x8*)(xc + (16 * mt + l15) * XC_PITCH + 64 * ks + 16 * g);
                ar[mt] = MFMA16(a, fa[ks], ar[mt]); ai[mt] = MFMA16(a, fx[ks], ai[mt]); } }
        float Ptot = 1.f;
#pragma unroll
        for (int mt = 0; mt < 4; ++mt) {
            float av[4], uv[4];
            {
                const f32x4 er4 = (ar[mt] + bav) * -1.4426950408889634f, ei4 = (ai[mt] + bxv) * -1.4426950408889634f; f32x4 dr, di;
#pragma unroll
                for (int i = 0; i < 4; ++i) { dr[i] = __builtin_amdgcn_exp2f(er4[i]); di[i] = __builtin_amdgcn_exp2f(ei4[i]); }
                dr = dr + 1.0f; di = di + 1.0f; f32x4 r4, ig4;
#pragma unroll
                for (int i = 0; i < 4; ++i) { r4[i] = __builtin_amdgcn_rcpf(dr[i]); ig4[i] = __builtin_amdgcn_rcpf(di[i]); }
                const f32x4 la4 = r4 * -sp8, ea4 = la4 * 1.4426950408889634f, t2 = la4 * 2.0f; f32x4 a4;
#pragma unroll
                for (int i = 0; i < 4; ++i) a4[i] = __builtin_amdgcn_exp2f(ea4[i]);
                const f32x4 om = -t2 * (t2 * (t2 * (t2 * (t2 * 0.008333334f + 0.041666668f) + 0.16666667f) + 0.5f) + 1.0f), dm = 1.0f - a4 * a4; f32x4 xc4;
#pragma unroll
                for (int i = 0; i < 4; ++i) xc4[i] = __builtin_bit_cast(float, (unsigned)(*(const LAS unsigned short*)(xc + (16 * mt + 4 * g + i) * XC_PITCH + 2 * c)) << 16);
                const f32x4 gx = ig4 * xc4;
#pragma unroll
                for (int i = 0; i < 4; ++i) { av[i] = a4[i]; uv[i] = __builtin_amdgcn_sqrtf(t2[i] > -0.5f ? om[i] : dm[i]) * gx[i]; }
            }
            float P = (av[0] * av[1]) * (av[2] * av[3]), H = ((uv[0] * av[1] + uv[1]) * av[2] + uv[2]) * av[3] + uv[3];
            { const float Pp = shup(P, 16, lane), Hp = shup(H, 16, lane); if (g >= 1) { H = P * Hp + H; P = P * Pp; } }
            { const float Pp = shup(P, 32, lane), Hp = shup(H, 32, lane); if (g >= 2) { H = P * Hp + H; P = P * Pp; } }
            float Pe = shup(P, 16, lane), He = shup(H, 16, lane); if (g == 0) { Pe = 1.f; He = 0.f; }
            const float P3 = shfrom(P, l15 + 48), H3 = shfrom(H, l15 + 48);
            if (pass == 1) { float hh = Pe * carry + He;
#pragma unroll
                for (int i = 0; i < 4; ++i) { hh = av[i] * hh + uv[i]; HS[(16 * mt + 4 * g + i) * HS_PITCH + c] = hh; } }
            carry = P3 * carry + H3; Ptot *= P3;
        }
        if (pass == 0) { if (g == 0) { ((float*)(p.ws + WS_RGP))[(size_t)tile * DR + ch] = Ptot; ((float*)(p.ws + WS_RGH))[(size_t)tile * DR + ch] = carry; } }
        else {
            LDS_BARRIER();
            bf16* Y = (bf16*)(p.ws + WS_U) + (size_t)tok * D + DR + blk * 128 + 16 * c8;
#pragma unroll
            for (int hf = 0; hf < 2; ++hf) { const v4u gv = gq[hf];
                const LAS float* hp = HS + tt * HS_PITCH + 16 * c8 + 8 * hf; const f32x4 h0 = *(const LAS f32x4*)hp, h1 = *(const LAS f32x4*)(hp + 4);
                v4u o; o.x = pk2(h0.x * gelu_tanh(bflo(gv.x)), h0.y * gelu_tanh(bfhi(gv.x))); o.y = pk2(h0.z * gelu_tanh(bflo(gv.y)), h0.w * gelu_tanh(bfhi(gv.y)));
                o.z = pk2(h1.x * gelu_tanh(bflo(gv.z)), h1.y * gelu_tanh(bfhi(gv.z))); o.w = pk2(h1.z * gelu_tanh(bflo(gv.w)), h1.w * gelu_tanh(bfhi(gv.w)));
                *(v4u*)(Y + 8 * hf) = o; }
        }
    }
    LDS_BARRIER();
}
__device__ __forceinline__ void rg_carry_unit(const Params& p, int unit, LAS unsigned char* lds) {
    const int tid = otid(p.wv), b = unit >> 4, cg0 = (unit & 15) * 64;
    LAS float* Pl = (LAS float*)lds; LAS float* Hl = (LAS float*)(lds + 32768);
    const float* RP = (const float*)(p.ws + WS_RGP); const float* RH = (const float*)(p.ws + WS_RGH); float* RC = (float*)(p.ws + WS_RGC);
    for (int i = tid; i < 128 * 64; i += 512) { const int tl = i >> 6, c = i & 63; const size_t o = (size_t)(b * 128 + tl) * DR + cg0 + c; Pl[i] = RP[o]; Hl[i] = RH[o]; }
    __syncthreads();
    {
        LAS float* Ps = (LAS float*)(lds + 65536); LAS float* Hs = Ps + 512;
        const int c = tid & 63, seg = tid >> 6;
        float P = 1.f, H = 0.f;
#pragma unroll 4
        for (int i = 0; i < 16; ++i) { const int o = (seg * 16 + i) * 64 + c; const float cp = Pl[o]; H = cp * H + Hl[o]; P *= cp; }
        Ps[seg * 64 + c] = P; Hs[seg * 64 + c] = H;
        __syncthreads();
        float carry = 0.f;
        for (int s = 0; s < seg; ++s) carry = Ps[s * 64 + c] * carry + Hs[s * 64 + c];
#pragma unroll 4
        for (int i = 0; i < 16; ++i) { const int o = (seg * 16 + i) * 64 + c; const float cp = Pl[o], chh = Hl[o]; Pl[o] = carry; carry = cp * carry + chh; }
    }
    __syncthreads();
    for (int i = tid; i < 128 * 64; i += 512) { const int tl = i >> 6, c = i & 63; RC[(size_t)(b * 128 + tl) * DR + cg0 + c] = Pl[i]; }
    __syncthreads();
}

__global__ void __launch_bounds__(512, 2) hybrid_fwd(Params p_in) {
    extern __shared__ __attribute__((aligned(16))) unsigned char lds_raw[];
    LAS unsigned char* lds = (LAS unsigned char*)lds_raw;
    cg::grid_group grid = cg::this_grid();
    Params p = p_in; p.wv = __builtin_amdgcn_readfirstlane((int)threadIdx.x >> 6);
    unsigned char* ws = p.ws;
    const int G = gridDim.x, bid = blockIdx.x;
    const float* mod = (const float*)(ws + WS_MOD);
    bf16* U = (bf16*)(ws + WS_U); bf16* Hb = (bf16*)(ws + WS_H);
    bf16* XB = (bf16*)(ws + WS_XBH);
    volatile LAS unsigned* xst = (volatile LAS unsigned*)(lds + LDS_BYTES - 64);
    { const int t0_ = otid(p.wv); if (t0_ < 16) xst[t0_] = 0u; }
    __syncthreads();
    (void)xcd_barrier_post((unsigned*)(ws + WS_BAR), xst, p.wv);
#define GRID_BAR() do { XcdBarrier xb_; xb_.bar = (unsigned*)(ws + WS_BAR); xb_.x = xb_xcc_id(); xb_.st = (volatile LAS unsigned*)(lds + LDS_BYTES - 64); xb_.wv = p.wv; xcd_barrier(xb_); } while (0)
#ifdef PROBE_MASK
#define PR_SLOT ((volatile LAS unsigned long long*)(lds + LDS_BYTES - 128))
    if (bid == 0 && otid(p.wv) == 0) { PR_SLOT[0] = __builtin_amdgcn_s_memrealtime(); PR_SLOT[1] = 0ull; }
#define PH_END(k) do { if (bid == 0 && otid(p.wv) == 0) { const unsigned long long now_ = __builtin_amdgcn_s_memrealtime(); if ((PROBE_MASK >> (k)) & 1) PR_SLOT[1] += now_ - PR_SLOT[0]; PR_SLOT[0] = now_; } } while (0)
#else
#define PH_END(k) do { } while (0)
#endif

    if (p.ws == nullptr) grid.sync();
    p0_prologue(p, lds);
    GRID_BAR(); PH_END(0);
    row_pass(p, kin(I_X), false, nullptr, -1, 0, false, UP8_0, true, true, lds);
    GRID_BAR(); PH_END(1);
    { pg8::Gemm gm{U, (const bf16*)(ws + WS_W13A), M, 2 * FF, UP8_0 ? D / 2 : D, p.wv}; pg8::StaticOrder S; S.init(M, 2 * FF, G, bid);
      pg8::EpiSwiglu<DN8_0> E{Hb, FF, UP8_0 ? 1.0f / (FP8_ASCALE * FP8_WSCALE) : 1.0f, FP8_HSCALE}; pg8::gemm_phase<pg8::EpiSwiglu<DN8_0>, pg8::StaticOrder, true, true, UP8_0>(lds, gm, S, E); }
    GRID_BAR(); PH_END(2);
    { pg8::Gemm gm{Hb, (const bf16*)(ws + WS_W2A), M, D, DN8_0 ? FF / 2 : FF, p.wv}; pg8::StaticOrder S; S.init(M, D, G, bid);
      pg8::EpiRes<false> E{kin(I_X), XB, mod + 0 * 3 * D + 2 * D, nullptr, DN8_0 ? 0.5f / (FP8_HSCALE * FP8_W2SCALE) : 0.5f, 0}; pg8::gemm_phase<pg8::EpiRes<false>, pg8::StaticOrder, true, true, DN8_0>(lds, gm, S, E); }
    GRID_BAR(); PH_END(3);
    row_pass(p, XB, true, nullptr, 0, 1, true, false, false, false, lds);
    GRID_BAR(); PH_END(4);
    { pg8::Gemm gm{U, (const bf16*)(ws + WS_WIN), M, NPROJ, D, p.wv}; pg8::StaticOrder S; S.init(M, NPROJ, G, bid);
      pg8::EpiProj E{(bf16*)(ws + WS_PROJ), kin(I_BIN)}; pg8::gemm_phase<pg8::EpiProj, pg8::StaticOrder, true, true>(lds, gm, S, E); }
    GRID_BAR(); PH_END(5);
    for (int u = bid; u < 8 * NSC; u += G) m1_unit(p, u / NSC, u % NSC, lds);
    rg_phase(p, 0, lds);
    GRID_BAR(); PH_END(6);
    m2_scan(p);
    for (int u = bid; u < 32; u += G) rg_carry_unit(p, u, lds);
    GRID_BAR(); PH_END(7);
    for (int u = bid; u < 8 * NSC; u += G) m3_unit(p, u / NSC, u % NSC, lds);
    rg_phase(p, 1, lds);
    GRID_BAR(); PH_END(8);
    { pg8::Gemm gm{U, (const bf16*)(ws + WS_WOUT), M, D, D, p.wv}; pg8::StaticOrder S; S.init(M, D, G, bid);
      pg8::EpiRes<true> E{XB, XB, mod + 1 * 3 * D + 2 * D, (const float*)(ws + WS_STAT), 1.0f, 0};        pg8::gemm_phase<pg8::EpiRes<true>, pg8::StaticOrder, true, true>(lds, gm, S, E); }
    GRID_BAR(); PH_END(9);
    row_pass(p, XB, true, nullptr, 1, 2, false, UP8_1, false, false, lds);
    GRID_BAR(); PH_END(10);
    { pg8::Gemm gm{U, (const bf16*)(ws + WS_W13B), M, 2 * FF, UP8_1 ? D / 2 : D, p.wv}; pg8::StaticOrder S; S.init(M, 2 * FF, G, bid);
      pg8::EpiSwiglu<DN8_1> E{Hb, FF, UP8_1 ? 1.0f / (FP8_ASCALE * FP8_WSCALE) : 1.0f, FP8_HSCALE}; pg8::gemm_phase<pg8::EpiSwiglu<DN8_1>, pg8::StaticOrder, true, true, UP8_1>(lds, gm, S, E); }
    GRID_BAR(); PH_END(11);
    { pg8::Gemm gm{Hb, (const bf16*)(ws + WS_W2B), M, D, DN8_1 ? FF / 2 : FF, p.wv}; pg8::StaticOrder S; S.init(M, D, G, bid);
      pg8::EpiRes<true> E{XB, XB, mod + 2 * 3 * D + 2 * D, (const float*)(ws + WS_STAT), DN8_1 ? 0.5f / (FP8_HSCALE * FP8_W2SCALE) : 0.5f, 1};        pg8::gemm_phase<pg8::EpiRes<true>, pg8::StaticOrder, true, true, DN8_1>(lds, gm, S, E); }
    GRID_BAR(); PH_END(12);
    row_pass(p, XB, true, p.out, 2, -1, false, false, false, true, lds);
#ifdef PROBE_MASK
    grid.sync(); PH_END(13);
    if (bid == 0 && otid(p.wv) == 0) { *(volatile float*)(ws + WS_MDEC + 65536) = sqrtf((float)PR_SLOT[1] * 0.01f * 1e-5f); __threadfence(); }
    grid.sync();
    { const float E = *(volatile float*)(ws + WS_MDEC + 65536);
      for (int i = bid * 512 + otid(p.wv); i < M * D / 1024; i += G * 512) XB[(size_t)i * 1024] += E; }
#endif
}

extern "C" void kernel_launch(void* const* d_in, const int* in_sizes, int n_in, void* d_out, int out_size, void* d_ws, size_t ws_size, hipStream_t stream) {
    static int grid = 0;
    if (grid == 0) {
        if (n_in != 21 || out_size != M * D || ws_size < WS_END) { fprintf(stderr, "kernel_launch: unexpected shapes (n_in %d, out %d, ws %zu < %zu)\n", n_in, out_size, ws_size, (size_t)WS_END); grid = -1; return; }
        int dev = 0, cus = 0, per_cu = 0;
        hipGetDevice(&dev); hipDeviceGetAttribute(&cus, hipDeviceAttributeMultiprocessorCount, dev);
        if (hipFuncSetAttribute((const void*)hybrid_fwd, hipFuncAttributeMaxDynamicSharedMemorySize, LDS_BYTES) != hipSuccess) { fprintf(stderr, "kernel_launch: hipFuncSetAttribute failed\n"); grid = -1; return; }
        if (hipOccupancyMaxActiveBlocksPerMultiprocessor(&per_cu, (const void*)hybrid_fwd, 512, LDS_BYTES) != hipSuccess || per_cu < 1) { fprintf(stderr, "kernel_launch: occupancy query gives %d\n", per_cu); per_cu = 1; }
        (void)hipGetLastError();
        grid = cus;
    }
    if (grid < 0) return;
    hipMemsetAsync((char*)d_ws + WS_BAR, 0, XCD_BAR_WORDS * sizeof(unsigned), stream);
    Params p{};
    for (int i = 0; i < 21; ++i) p.in[i] = (const float*)d_in[i];
    p.out = (float*)d_out; p.ws = (unsigned char*)d_ws;
    void* args[] = {&p};
    hipError_t e = hipLaunchCooperativeKernel((const void*)hybrid_fwd, dim3(grid), dim3(512), args, LDS_BYTES, stream);
    if (e != hipSuccess) fprintf(stderr, "cooperative launch failed: %s (grid %d)\n", hipGetErrorString(e), grid);
}
```

```cpp
#include <hip/hip_runtime.h>
#include <hip/hip_cooperative_groups.h>
#include <cstdio>
#include <cstdint>
namespace cg = cooperative_groups;
__device__ __forceinline__ int otid(int wv) { int t; asm volatile("v_mbcnt_lo_u32_b32 %0, -1, 0\n\tv_mbcnt_hi_u32_b32 %0, -1, %0" : "=v"(t)); return t + 64 * wv; }
__device__ __forceinline__ const float* kin(int i) { int o = __builtin_amdgcn_readfirstlane(i * 8); asm volatile("" : "+s"(o));
    typedef const float* cfp; return *(const __attribute__((address_space(4))) cfp*)((const __attribute__((address_space(4))) char*)__builtin_amdgcn_kernarg_segment_ptr() + o); }
#define UP8_CFG0 false
#define UP8_CFG1 true
#define DN8_CFG0 true
#define DN8_CFG1 true
namespace pg8 {
#define PG8_LAS __attribute__((address_space(3)))
typedef unsigned short bf16_t;
typedef short bf16x8 __attribute__((ext_vector_type(8)));
typedef float f32x4 __attribute__((ext_vector_type(4)));
typedef unsigned u32x4 __attribute__((ext_vector_type(4)));
constexpr int BM = 256, BK = 64, HALF = 128, HTB = HALF * BK * 2  , STAGE_BYTES = 8 * HTB, NXCD = 8, WGM = 4;

__host__ __device__ __forceinline__ int lds_byte(int r, int c) { const int st = (r >> 4) * 2 + (c >> 5), rr = r & 15, cc = c & 31, ob = rr * 64 + cc * 2; return st * 1024 + (ob ^ (((ob >> 9) & 1) << 5)); }
__host__ __device__ __forceinline__ void stage_rc(int b, int& R, int& C) { const int st = b / 1024, sb = b % 1024, swz = sb ^ (((sb >> 9) & 1) << 5); R = (st >> 1) * 16 + swz / 64; C = (st & 1) * 32 + (swz % 64) / 2; }
__host__ __device__ __forceinline__ int perm32(int rho) { const int n = rho >> 4, i = rho & 15; return 8 * (i >> 2) + 4 * n + (i & 3); }

struct Unit { int pm, pn; };
struct Gemm { const bf16_t* A; const bf16_t* Bt; int M, N, K, wv; };

struct StaticOrder {
    int nM, nN, nwg, G, c;
    __host__ __device__ void init(int M, int N, int G_, int c_) { nM = M / BM; nN = N / BM; nwg = nM * nN; G = G_; c = c_; }
    __host__ __device__ bool next(int i, Unit& u) const {
        const long L = (long)i * G + c; if (L >= nwg) return false;
        int wgid = (int)L; { const int q = nwg / NXCD, r = nwg % NXCD, xcd = wgid % NXCD, off = wgid / NXCD; wgid = (xcd < r ? xcd * (q + 1) : r * (q + 1) + (xcd - r) * q) + off; }
        const int nig = WGM * nN, gid = wgid / nig, fm = gid * WGM, gsz = (nM - fm) < WGM ? (nM - fm) : WGM;
        u.pm = fm + ((wgid % nig) % gsz); u.pn = (wgid % nig) / gsz; return true;
    }
    __device__ __forceinline__ void a_ready(const Unit&) const {}
    __device__ __forceinline__ void done(const Unit&) const {}
};
typedef int i32x8 __attribute__((ext_vector_type(8)));
__device__ __forceinline__ unsigned cvt_pk_bf16(float lo, float hi) { unsigned r; asm volatile("v_cvt_pk_bf16_f32 %0, %1, %2" : "=v"(r) : "v"(lo), "v"(hi)); return r; }
template <bool OUT8> struct EpiSwiglu {
    static constexpr bool PERM = true, AFTER_DRAIN = false;
    void* O; int ldc; float sc, hs;
    __device__ __forceinline__ void operator()(const f32x4 (&acc)[2][2][4][2], const Unit& u, int wr, int wc, int fr, int fq) const {
        const int row0 = u.pm * BM + wr * 64 + fr, col0 = u.pn * HALF + wc * 32 + 8 * fq;
        const float nsc = -1.4426950408889634f * sc, vs = sc * sc * (OUT8 ? hs : 1.0f);
#pragma unroll
        for (int ai = 0; ai < 2; ++ai)
#pragma unroll
            for (int m = 0; m < 4; ++m) {
                float h[8];
#pragma unroll
                for (int n = 0; n < 2; ++n) {
                    const f32x4 g4 = acc[ai][0][m][n], num = (g4 * acc[ai][1][m][n]) * vs, ea = g4 * nsc; f32x4 den;
#pragma unroll
                    for (int j = 0; j < 4; ++j) den[j] = __builtin_amdgcn_exp2f(ea[j]);
                    den = den + 1.0f;
#pragma unroll
                    for (int j = 0; j < 4; ++j) h[4 * n + j] = num[j] * __builtin_amdgcn_rcpf(den[j]); }
                const size_t off = (size_t)(row0 + ai * HALF + m * 16) * ldc + col0;
                if constexpr (OUT8) { unsigned w0 = 0u, w1 = 0u;
                    w0 = __builtin_amdgcn_cvt_pk_fp8_f32(h[0], h[1], w0, false); w0 = __builtin_amdgcn_cvt_pk_fp8_f32(h[2], h[3], w0, true);
                    w1 = __builtin_amdgcn_cvt_pk_fp8_f32(h[4], h[5], w1, false); w1 = __builtin_amdgcn_cvt_pk_fp8_f32(h[6], h[7], w1, true);
                    typedef unsigned u32x2 __attribute__((ext_vector_type(2))); *(u32x2*)((unsigned char*)O + off) = (u32x2){w0, w1};
                } else { u32x4 w; w.x = cvt_pk_bf16(h[0], h[1]); w.y = cvt_pk_bf16(h[2], h[3]); w.z = cvt_pk_bf16(h[4], h[5]); w.w = cvt_pk_bf16(h[6], h[7]);
                    *(u32x4*)((bf16_t*)O + off) = w; } }
    }
};
typedef _Float16 f16x4 __attribute__((ext_vector_type(4)));
template <bool LNRES> struct EpiRes {
    static constexpr bool PERM = false, AFTER_DRAIN = false;
    const void* res; bf16_t* out; const float* gate; const float* stat; float coef; int ln_idx;
    static constexpr int gate_bstride = 18432; static constexpr float alpha = 1.189207115002721f;
    __device__ __forceinline__ void operator()(const f32x4 (&acc)[2][2][4][2], const Unit& u, int wr, int wc, int fr, int fq) const {
        typedef float f32x2v __attribute__((ext_vector_type(2))); typedef unsigned u32x2 __attribute__((ext_vector_type(2)));
        const void* const res_ = res; bf16_t* const out_ = out; const float* const gate_ = gate; const float coef_ = coef; const float* const stat_ = stat; const int ln_ = ln_idx;
        const int row0 = u.pm * BM + wr * 64 + fr, col0 = u.pn * BM + wc * 32 + 4 * fq;
        const float* gp = gate_ + (size_t)(u.pm >> 5) * gate_bstride + col0;
#pragma unroll
        for (int bj = 0; bj < 2; ++bj)
#pragma unroll
            for (int n = 0; n < 2; ++n) {
                const int co = bj * HALF + n * 16;
                const f32x4 gv = *(const f32x4*)(gp + co) * coef_;
                f32x4 lg = {1.f, 1.f, 1.f, 1.f}, lb = {0.f, 0.f, 0.f, 0.f};
                if constexpr (LNRES) { lg = *(const f32x4*)(kin(19) + ln_ * 2048 + col0 + co); lb = *(const f32x4*)(kin(20) + ln_ * 2048 + col0 + co); }
#pragma unroll
                for (int ai = 0; ai < 2; ++ai)
#pragma unroll
                    for (int m = 0; m < 4; ++m) { const int row = row0 + ai * HALF + m * 16; const size_t off = (size_t)row * 2048 + col0 + co;
                        f32x4 r;
                        if constexpr (LNRES) { r = __builtin_convertvector(*(const f16x4*)((const bf16_t*)res_ + off), f32x4);
                            const f32x2v st = *(const f32x2v*)(stat_ + 2 * (size_t)row); r = (r - st.x) * st.y * lg + lb; }
                        else r = __builtin_nontemporal_load((const f32x4*)((const float*)res_ + off));
                        const f32x4 z = r * alpha + gv * acc[ai][bj][m][n];
                        *(f16x4*)(out_ + off) = __builtin_convertvector(z, f16x4); }
                if (bj == 0 && n == 1) __builtin_amdgcn_sched_barrier(0); }
    }
};
struct EpiProj {
    static constexpr bool PERM = true, AFTER_DRAIN = false;
    bf16_t* O; const float* bias;
    __device__ __forceinline__ void operator()(const f32x4 (&acc)[2][2][4][2], const Unit& u, int wr, int wc, int fr, int fq) const {
        const int row0 = u.pm * BM + wr * 64 + fr; const int colt = u.pn * BM; const int t = colt >> 10;
        bf16_t* base = O + (size_t)t * ((size_t)16384 * 1024);
        const int col0 = (colt & 1023) + wc * 32 + 8 * fq, bcol0 = colt + (colt >= 4096 ? 8 : 0) + wc * 32 + 8 * fq;
        f32x4 bv[2][2];
#pragma unroll
        for (int bj = 0; bj < 2; ++bj)
#pragma unroll
            for (int n = 0; n < 2; ++n) { const float* bp = bias + bcol0 + bj * HALF + 4 * n; bv[bj][n] = (f32x4){bp[0], bp[1], bp[2], bp[3]}; }
#pragma unroll
        for (int ai = 0; ai < 2; ++ai)
#pragma unroll
            for (int m = 0; m < 4; ++m) { bf16_t* rowp = base + (size_t)(row0 + ai * HALF + m * 16) * 1024 + col0;
#pragma unroll
                for (int bj = 0; bj < 2; ++bj) { const f32x4 v0 = acc[ai][bj][m][0] + bv[bj][0], v1 = acc[ai][bj][m][1] + bv[bj][1];
                    u32x4 w; w.x = cvt_pk_bf16(v0[0], v0[1]); w.y = cvt_pk_bf16(v0[2], v0[3]); w.z = cvt_pk_bf16(v1[0], v1[1]); w.w = cvt_pk_bf16(v1[2], v1[3]);
                    *(u32x4*)(rowp + bj * HALF) = w; } }
    }
};
template <class Epi, class Sched, bool ALIGN_EPI = false, bool SP2 = false, bool FP8 = false>
__device__ __forceinline__ void gemm_phase(PG8_LAS unsigned char* lds, const Gemm g, const Sched& S, const Epi& E) {
    const int tid = otid(g.wv), wid = __builtin_amdgcn_readfirstlane(tid >> 6), lane = tid & 63, wr = wid >> 2, wc = wid & 3, fr = lane & 15, fq = lane >> 4;
    const int K = g.K, nt = K / BK;
    unsigned voffA, voffB;
    { int R, C; stage_rc(tid * 16, R, C); const int Rb = Epi::PERM ? ((R & ~31) + perm32(R & 31)) : R;
        voffA = (unsigned)(R * K + C) * 2u; voffB = (unsigned)(Rb * K + C) * 2u; }
    const size_t istep = (size_t)64 * K * 2;
    const size_t kstep = (size_t)(BK * 2);
    const size_t hstep = (size_t)HALF * K * 2;
    const size_t tstep = 2 * hstep;
    const unsigned ldsw = (unsigned)wid * 1024u;
    const int aoff = lds_byte(wr * 64 + fr, fq * 8), boff = lds_byte(wc * 32 + fr, fq * 8);
#define PG8_SA(b, h) (((b) * 2 + (h)) * HTB)
#define PG8_SB(b, h) ((4 + (b) * 2 + (h)) * HTB)
#define PG8_STAGE(bufoff, gbase, voff) do { _Pragma("unroll") for (int _i = 0; _i < 2; ++_i) \
        __builtin_amdgcn_global_load_lds((const unsigned*)((const char*)(gbase) + (size_t)_i * istep + (voff)), (PG8_LAS unsigned*)(lds + (bufoff) + ldsw + _i * 8192), 16, 0, 0); } while (0)
#define PG8_LDA(dst, b, h) do { _Pragma("unroll") for (int m = 0; m < 4; ++m) _Pragma("unroll") for (int k = 0; k < 2; ++k) dst[m][k] = *(const PG8_LAS bf16x8*)(lds + PG8_SA(b, h) + aoff + m * 2048 + k * 1024); } while (0)
#define PG8_LDB(dst, b, h) do { _Pragma("unroll") for (int n = 0; n < 2; ++n) _Pragma("unroll") for (int k = 0; k < 2; ++k) dst[n][k] = *(const PG8_LAS bf16x8*)(lds + PG8_SB(b, h) + boff + n * 2048 + k * 1024); } while (0)
#define PG8_MMA(ai, bj, At, Bt) do { __builtin_amdgcn_s_setprio(1); _Pragma("unroll") for (int m = 0; m < 4; ++m) _Pragma("unroll") for (int n = 0; n < 2; ++n) { \
        if constexpr (FP8) { acc[ai][bj][m][n] = __builtin_amdgcn_mfma_scale_f32_16x16x128_f8f6f4(__builtin_bit_cast(i32x8, __builtin_shufflevector(Bt[n][0], Bt[n][1], 0, 1, 2, 3, 4, 5, 6, 7, 8, 9, 10, 11, 12, 13, 14, 15)), \
                __builtin_bit_cast(i32x8, __builtin_shufflevector(At[m][0], At[m][1], 0, 1, 2, 3, 4, 5, 6, 7, 8, 9, 10, 11, 12, 13, 14, 15)), acc[ai][bj][m][n], 0, 0, 0, 0x7F7F7F7F, 0, 0x7F7F7F7F); } \
        else { _Pragma("unroll") for (int k = 0; k < 2; ++k) acc[ai][bj][m][n] = __builtin_amdgcn_mfma_f32_16x16x32_bf16(Bt[n][k], At[m][k], acc[ai][bj][m][n], 0, 0, 0); } } \
        __builtin_amdgcn_s_setprio(0); } while (0)
#define PG8_WAIT_V(n) asm volatile("s_waitcnt vmcnt(" #n ")" ::: "memory")
#define PG8_WAIT_L(n) asm volatile("s_waitcnt lgkmcnt(" #n ")" ::: "memory")
#define PG8_BAR __builtin_amdgcn_s_barrier()
#define PG8_SCHED __builtin_amdgcn_sched_barrier(0)
    Unit cur, nxt; int ui = 0;
    if (!S.next(0, cur)) return;
    f32x4 acc[2][2][4][2];
#pragma unroll
    for (int a = 0; a < 2; ++a)
#pragma unroll
        for (int b = 0; b < 2; ++b)
#pragma unroll
            for (int m = 0; m < 4; ++m)
#pragma unroll
                for (int n = 0; n < 2; ++n) acc[a][b][m][n] = (f32x4){0.f, 0.f, 0.f, 0.f};
    bf16x8 At[4][2], B0[2][2], B1[2][2];
    const char* cA = (const char*)g.A + (size_t)cur.pm * tstep; const char* cB = (const char*)g.Bt + (size_t)cur.pn * tstep;
    S.a_ready(cur);
    if constexpr (SP2) {
        PG8_STAGE(PG8_SB(0, 0), cB, voffB); PG8_STAGE(PG8_SB(0, 1), cB + hstep, voffB); PG8_STAGE(PG8_SA(0, 0), cA, voffA); PG8_STAGE(PG8_SA(0, 1), cA + hstep, voffA);
        if (wr == 1) PG8_BAR;
        PG8_WAIT_V(2); PG8_BAR;
        PG8_STAGE(PG8_SB(1, 0), cB + kstep, voffB); PG8_STAGE(PG8_SA(1, 0), cA + kstep, voffA); PG8_STAGE(PG8_SB(1, 1), cB + hstep + kstep, voffB);
        PG8_WAIT_V(6); PG8_BAR;
    } else {
        PG8_STAGE(PG8_SB(0, 0), cB, voffB); PG8_STAGE(PG8_SA(0, 0), cA, voffA); PG8_STAGE(PG8_SB(0, 1), cB + hstep, voffB); PG8_STAGE(PG8_SA(0, 1), cA + hstep, voffA);
        if (wr == 1) PG8_BAR;
        PG8_WAIT_V(4); PG8_BAR;
        PG8_STAGE(PG8_SB(1, 0), cB + kstep, voffB); PG8_STAGE(PG8_SA(1, 0), cA + kstep, voffA); PG8_STAGE(PG8_SB(1, 1), cB + hstep + kstep, voffB);
        PG8_WAIT_V(6); PG8_BAR;
    }
    for (;;) {
        const bool has_next = S.next(ui + 1, nxt);
        const char* nA = has_next ? (const char*)g.A + (size_t)nxt.pm * tstep : cA; const char* nB = has_next ? (const char*)g.Bt + (size_t)nxt.pn * tstep : cB;
        for (int t = 0; t < nt; t += 2) {
            const bool last = (t == nt - 2);
            const char* a1 = cA + (size_t)(t + 1) * kstep;
            const char* a2 = last ? nA : cA + (size_t)(t + 2) * kstep; const char* b2 = last ? nB : cB + (size_t)(t + 2) * kstep;
            const char* a3 = a2 + kstep; const char* b3 = b2 + kstep;
            if (last && has_next) S.a_ready(nxt);
            if constexpr (SP2) {
            PG8_LDB(B0, 0, 0); PG8_LDB(B1, 0, 1); PG8_SCHED; PG8_LDA(At, 0, 0); PG8_STAGE(PG8_SA(1, 1), a1 + hstep, voffA);
            PG8_WAIT_V(8); PG8_WAIT_L(0); PG8_BAR; PG8_MMA(0, 0, At, B0); PG8_MMA(0, 1, At, B1); PG8_BAR; PG8_SCHED;
            PG8_LDA(At, 0, 1); PG8_STAGE(PG8_SB(0, 0), b2, voffB); PG8_STAGE(PG8_SB(0, 1), b2 + hstep, voffB); PG8_STAGE(PG8_SA(0, 0), a2, voffA);
            PG8_WAIT_V(8); PG8_WAIT_L(0); PG8_BAR; PG8_MMA(1, 0, At, B0); PG8_MMA(1, 1, At, B1); PG8_BAR; PG8_SCHED;
            PG8_LDB(B0, 1, 0); PG8_LDB(B1, 1, 1); PG8_SCHED; PG8_LDA(At, 1, 0); PG8_STAGE(PG8_SA(0, 1), a2 + hstep, voffA);
            PG8_WAIT_V(8); PG8_WAIT_L(0); PG8_BAR; PG8_MMA(0, 0, At, B0); PG8_MMA(0, 1, At, B1); PG8_BAR; PG8_SCHED;
            PG8_LDA(At, 1, 1); PG8_STAGE(PG8_SB(1, 0), b3, voffB); PG8_STAGE(PG8_SB(1, 1), b3 + hstep, voffB); PG8_STAGE(PG8_SA(1, 0), a3, voffA);
            PG8_WAIT_V(8); PG8_WAIT_L(0); PG8_BAR; PG8_MMA(1, 0, At, B0); PG8_MMA(1, 1, At, B1); PG8_BAR; PG8_SCHED;
            } else {
            PG8_LDB(B0, 0, 0); PG8_SCHED; PG8_LDA(At, 0, 0); PG8_STAGE(PG8_SA(1, 1), a1 + hstep, voffA);
            PG8_WAIT_L(8); PG8_BAR; PG8_WAIT_L(0); PG8_MMA(0, 0, At, B0); PG8_BAR; PG8_SCHED;
            PG8_LDB(B1, 0, 1); PG8_STAGE(PG8_SB(0, 0), b2, voffB);
            PG8_BAR; PG8_WAIT_L(0); PG8_MMA(0, 1, At, B1); PG8_BAR;
            PG8_LDA(At, 0, 1); PG8_STAGE(PG8_SA(0, 0), a2, voffA);
            PG8_BAR; PG8_WAIT_L(0); PG8_MMA(1, 0, At, B0); PG8_BAR; PG8_SCHED;
            PG8_STAGE(PG8_SB(0, 1), b2 + hstep, voffB);
            PG8_WAIT_V(6); PG8_BAR; PG8_MMA(1, 1, At, B1); PG8_BAR;
            PG8_LDB(B0, 1, 0); PG8_SCHED; PG8_LDA(At, 1, 0); PG8_STAGE(PG8_SA(0, 1), a2 + hstep, voffA);
            PG8_WAIT_L(8); PG8_BAR; PG8_WAIT_L(0); PG8_MMA(0, 0, At, B0); PG8_BAR; PG8_SCHED;
            PG8_LDB(B1, 1, 1); PG8_STAGE(PG8_SB(1, 0), b3, voffB);
            PG8_BAR; PG8_WAIT_L(0); PG8_MMA(0, 1, At, B1); PG8_BAR;
            PG8_LDA(At, 1, 1); PG8_STAGE(PG8_SA(1, 0), a3, voffA);
            PG8_BAR; PG8_WAIT_L(0); PG8_MMA(1, 0, At, B0); PG8_BAR; PG8_SCHED;
            PG8_STAGE(PG8_SB(1, 1), b3 + hstep, voffB);
            PG8_WAIT_V(6); PG8_BAR; PG8_MMA(1, 1, At, B1); PG8_BAR;
            }
        }
        if constexpr (ALIGN_EPI) { if (wr == 0) PG8_BAR; }
        if constexpr (!Epi::AFTER_DRAIN) { const int t2_ = otid(g.wv), fr_ = t2_ & 15, fq_ = (t2_ >> 4) & 3; E(acc, cur, wr, wc, fr_, fq_); S.done(cur); }
        if (!has_next) break;
#pragma unroll
        for (int a = 0; a < 2; ++a)
#pragma unroll
            for (int b = 0; b < 2; ++b)
#pragma unroll
                for (int m = 0; m < 4; ++m)
#pragma unroll
                    for (int n = 0; n < 2; ++n) acc[a][b][m][n] = (f32x4){0.f, 0.f, 0.f, 0.f};
        cur = nxt; cA = nA; cB = nB; ++ui;
        if constexpr (ALIGN_EPI) { if (wr == 1) PG8_BAR; }
    }
    PG8_WAIT_V(0);
    if constexpr (!ALIGN_EPI) { if (wr == 0) PG8_BAR; }
    PG8_BAR;
    if constexpr (Epi::AFTER_DRAIN) { E.fused(acc, cur, wr, wc, fr, fq, lds, wid, lane); S.done(cur); }
#undef PG8_SA
#undef PG8_SB
#undef PG8_STAGE
#undef PG8_LDA
#undef PG8_LDB
#undef PG8_MMA
#undef PG8_WAIT_V
#undef PG8_WAIT_L
#undef PG8_BAR
#undef PG8_SCHED
}
}

#define LAS __attribute__((address_space(3)))
typedef unsigned short bf16;
typedef unsigned v4u __attribute__((ext_vector_type(4)));
typedef unsigned v2u __attribute__((ext_vector_type(2)));
typedef float f32x4 __attribute__((ext_vector_type(4)));
typedef short bf16x8 __attribute__((ext_vector_type(8)));
typedef short s16x4 __attribute__((ext_vector_type(4)));

constexpr int NBATCH = 2, SEQ = 8192, M = NBATCH * SEQ, D = 2048, FF = 5632, DH = 256, NH = 4, DR = 1024;
constexpr int NMOD = 18432, INCOLS = 6152, NPROJ = 6144;
constexpr int SC = 256, NSC = SEQ / SC;
constexpr int CROWS = 272;
constexpr float ALPHA = 1.189207115002721f;
constexpr float LN_EPS = 1e-5f;
constexpr size_t MiB = (size_t)1 << 20;
constexpr size_t WS_MOD = 0, WS_BAR = 160 * 1024, WS_ZERO_BYTES = 256 * 1024;
constexpr size_t WS_WGT = 1 * MiB, WS_GATES = 2 * MiB, WS_MDEC = 3 * MiB, WS_QP = 3 * MiB + 256 * 1024, WS_STAT = 7 * MiB  , WS_RGP = 4 * MiB, WS_RGH = 5 * MiB, WS_RGC = 6 * MiB;
constexpr size_t WS_WAT = 8 * MiB, WS_WXT = 8 * MiB + 512 * 1024;
constexpr size_t WS_WOUT = 9 * MiB, WS_WIN = 17 * MiB, WS_W13A = 41 * MiB, WS_W13B = 85 * MiB, WS_W2A = 107 * MiB, WS_W2B = 118 * MiB;
constexpr size_t WS_U = 129 * MiB;
constexpr size_t WS_H = 193 * MiB;
constexpr size_t WS_PROJ = 193 * MiB;
constexpr size_t WS_DC = 385 * MiB;
constexpr size_t WS_CB = 453 * MiB;
constexpr int NKC = 28;
constexpr size_t WS_MODP = 487 * MiB;
constexpr size_t WS_XBH = 492 * MiB;
constexpr size_t WS_END = 556 * MiB;
constexpr int LDS_BYTES = 135168;

struct Params { const float* in[21]; float* out; unsigned char* ws; int wv, pad; };
enum { I_X = 0, I_C, I_WADA, I_BADA, I_F1W13, I_F1W2, I_WIN, I_BIN, I_MNG, I_CONVW, I_CONVB, I_WA, I_BA, I_WX, I_BX, I_LAM, I_WOUT, I_F2W13, I_F2W2, I_LNG, I_LNB };

#define LDS_BARRIER() do { asm volatile("s_waitcnt lgkmcnt(0)" ::: "memory"); __builtin_amdgcn_s_barrier(); asm volatile("" ::: "memory"); } while (0)
#define LDS_WAIT() asm volatile("s_waitcnt lgkmcnt(0)" ::: "memory")
__device__ __forceinline__ unsigned f2bf(float f) { unsigned u = __builtin_bit_cast(unsigned, f); return (u + 0x7fffu + ((u >> 16) & 1u)) >> 16; }
__device__ __forceinline__ unsigned pk2(float lo, float hi) { unsigned r; asm("v_cvt_pk_bf16_f32 %0, %1, %2" : "=v"(r) : "v"(lo), "v"(hi)); return r; }
__device__ __forceinline__ float bflo(unsigned w) { return __builtin_bit_cast(float, w << 16); }
__device__ __forceinline__ float bfhi(unsigned w) { return __builtin_bit_cast(float, w & 0xffff0000u); }
__device__ __forceinline__ float shx(float v, int m, int lane) { return __builtin_bit_cast(float, __builtin_amdgcn_ds_bpermute((lane ^ m) << 2, __builtin_bit_cast(int, v))); }
__device__ __forceinline__ float shup(float v, int d, int lane) { const int s = lane - d; return __builtin_bit_cast(float, __builtin_amdgcn_ds_bpermute((s < 0 ? lane : s) << 2, __builtin_bit_cast(int, v))); }
__device__ __forceinline__ float shfrom(float v, int src) { return __builtin_bit_cast(float, __builtin_amdgcn_ds_bpermute(src << 2, __builtin_bit_cast(int, v))); }
__device__ __forceinline__ float wave_sum(float v, int lane) {
#pragma unroll
    for (int o = 1; o < 64; o <<= 1) v += shx(v, o, lane);
    return v;
}
__device__ __forceinline__ float sigm(float x) { return __builtin_amdgcn_rcpf(1.0f + __builtin_amdgcn_exp2f(-1.4426950408889634f * x)); }
__device__ __forceinline__ float logsigm(float x) { return x < 0.f ? x - log1pf(__expf(x)) : -log1pf(__expf(-x)); }
__device__ __forceinline__ s16x4 tr_read(LAS unsigned char* p) {
    typedef short v4i16_t __attribute__((ext_vector_type(4)));
    return __builtin_bit_cast(s16x4, __builtin_amdgcn_ds_read_tr16_b64_v4i16((LAS v4i16_t*)p));
}
__device__ __forceinline__ bf16x8 cat8(s16x4 lo, s16x4 hi) { return __builtin_shufflevector(lo, hi, 0, 1, 2, 3, 4, 5, 6, 7); }
__device__ __forceinline__ unsigned pk4_fp8(float a, float b, float c, float d) { unsigned w = 0u;
    a = __builtin_amdgcn_fmed3f(a, -448.0f, 448.0f); b = __builtin_amdgcn_fmed3f(b, -448.0f, 448.0f); c = __builtin_amdgcn_fmed3f(c, -448.0f, 448.0f); d = __builtin_amdgcn_fmed3f(d, -448.0f, 448.0f);
    w = __builtin_amdgcn_cvt_pk_fp8_f32(a, b, w, false); w = __builtin_amdgcn_cvt_pk_fp8_f32(c, d, w, true); return w; }
constexpr float FP8_ASCALE = 4.0f, FP8_WSCALE = 64.0f;
constexpr float FP8_HSCALE = 2.0f, FP8_W2SCALE = 128.0f;
constexpr bool UP8_0 = UP8_CFG0, UP8_1 = UP8_CFG1, DN8_0 = DN8_CFG0, DN8_1 = DN8_CFG1;
static_assert(!UP8_0 && UP8_1 && DN8_0 && DN8_1, "the workspace map sizes the weight / H buffers for this fp8 configuration");
#define MFMA16(a, b, c) __builtin_amdgcn_mfma_f32_16x16x32_bf16((a), (b), (c), 0, 0, 0)

#define XB_TMO      128
#define XB_XCNT(j)  (256  + 64 * (j))
#define XB_XSUB(j)  (1280 + 64 * (j))
#define XB_XGEN(j)  (2304 + 64 * (j))
#define XB_TOP      3328
#define XB_TOPGEN   3392
#define XCD_BAR_WORDS 3456
#define XB_SPIN_CAP (1u << 18)

__device__ __forceinline__ unsigned xb_ld(unsigned* p)              { return __hip_atomic_load(p, __ATOMIC_RELAXED, __HIP_MEMORY_SCOPE_AGENT); }
__device__ __forceinline__ unsigned xb_add(unsigned* p, unsigned v) { return __hip_atomic_fetch_add(p, v, __ATOMIC_RELAXED, __HIP_MEMORY_SCOPE_AGENT); }
__device__ __forceinline__ unsigned xb_xcc_id() { return (unsigned)__builtin_amdgcn_s_getreg((3 << 11) | 20) & 0xFu; }
#define XB_SPIN(cond, bar) do { unsigned _sp = 0; while (cond) { __builtin_amdgcn_s_sleep(1); \
    if ((++_sp & 255u) == 0u) { if (xb_ld(&(bar)[XB_TMO])) break; if (_sp > XB_SPIN_CAP) { atomicAdd(&(bar)[XB_TMO], 1u); break; } } } } while (0)

struct XcdBarrier {
    unsigned* bar; unsigned x; int wv;
    volatile LAS unsigned* st;
};

__device__ __forceinline__ XcdBarrier xcd_barrier_post(unsigned* bar, volatile LAS unsigned* st, int wv) {
    XcdBarrier b; b.bar = bar; b.x = xb_xcc_id(); b.st = st; b.wv = wv;
    if (otid(wv) == 0) (void)xb_add(&bar[XB_XCNT(b.x)], 1u);
    return b;
}
__device__ __forceinline__ void xcd_barrier_complete(unsigned* bar, unsigned x, unsigned& nloc, unsigned& nx) {
    const unsigned G = gridDim.x * gridDim.y * gridDim.z;
    unsigned sum, cnt, mine, sp = 0u;
    for (;;) {
        sum = 0u; cnt = 0u; mine = 0u;
#pragma unroll
        for (unsigned j = 0; j < 16; ++j) { const unsigned c = xb_ld(&bar[XB_XCNT(j)]); sum += c; cnt += (c > 0u) ? 1u : 0u; mine = (j == x) ? c : mine; }
        if (sum == G) break;
        __builtin_amdgcn_s_sleep(1);
        if ((++sp & 255u) == 0u) { if (xb_ld(&bar[XB_TMO])) break; if (sp > XB_SPIN_CAP) { atomicAdd(&bar[XB_TMO], 1u); break; } }
    }
    nloc = mine > 0u ? mine : 1u; nx = cnt > 0u ? cnt : 1u;
}

__device__ __forceinline__ void xcd_barrier(const XcdBarrier& b) {
    asm volatile("s_waitcnt vmcnt(0)" ::: "memory");
    __syncthreads();
    if (otid(b.wv) == 0) {
        unsigned* bar = b.bar;
        __builtin_amdgcn_s_waitcnt(0);
        unsigned nloc = b.st[0], nx = b.st[1];
        if (nloc == 0u) { xcd_barrier_complete(bar, b.x, nloc, nx); b.st[0] = nloc; b.st[1] = nx; }
        const unsigned old = xb_add(&bar[XB_XSUB(b.x)], 1u);
        const unsigned gen = old / nloc;
        if (old + 1u == (gen + 1u) * nloc) {
            __builtin_amdgcn_fence(__ATOMIC_RELEASE, "agent");
            asm volatile("s_waitcnt vmcnt(0)" ::: "memory");
            const unsigned og = xb_add(&bar[XB_TOP], 1u);
            const unsigned tg = og / nx;
            if (og + 1u == (tg + 1u) * nx) xb_add(&bar[XB_TOPGEN], 1u);
            else XB_SPIN(xb_ld(&bar[XB_TOPGEN]) == tg, bar);
            __builtin_amdgcn_fence(__ATOMIC_ACQUIRE, "agent");
            xb_add(&bar[XB_XGEN(b.x)], 1u);
            asm volatile("s_waitcnt vmcnt(0)" ::: "memory");
        } else {
            XB_SPIN(xb_ld(&bar[XB_XGEN(b.x)]) == gen, bar);
            __builtin_amdgcn_fence(__ATOMIC_ACQUIRE, "agent");
            asm volatile("s_waitcnt vmcnt(0)" ::: "memory");
        }
    }
    __syncthreads();
}

__device__ __forceinline__ void tr_item(const float* __restrict__ W, int ldw, int K, int src_col, bf16* __restrict__ WT, int dst_row, int k0, LAS float* scr, int lane) {
#pragma unroll 8
    for (int i = 0; i < 32; ++i) { const int kk = 2 * i + (lane >> 5); scr[kk * 33 + (lane & 31)] = __builtin_nontemporal_load(W + (size_t)(k0 + kk) * ldw + src_col + (lane & 31));     }
    LDS_WAIT();
    const int c = lane & 7;
#pragma unroll
    for (int j = 0; j < 4; ++j) { const int n = (lane >> 3) + 8 * j; const LAS float* s = scr + (8 * c) * 33 + n;
        v4u o; o.x = pk2(s[0 * 33], s[1 * 33]); o.y = pk2(s[2 * 33], s[3 * 33]); o.z = pk2(s[4 * 33], s[5 * 33]); o.w = pk2(s[6 * 33], s[7 * 33]);
        *(v4u*)(WT + (size_t)(dst_row + n) * K + k0 + 8 * c) = o; }
    LDS_WAIT();
}
__device__ __forceinline__ void tr_item8(const float* __restrict__ W, int ldw, int K, int src_col, unsigned char* __restrict__ WT, int dst_row, int k0, LAS float* scr, int lane, float wsc) {
#pragma unroll 8
    for (int i = 0; i < 32; ++i) { const int kk = 2 * i + (lane >> 5); scr[kk * 33 + (lane & 31)] = __builtin_nontemporal_load(W + (size_t)(k0 + kk) * ldw + src_col + (lane & 31));     }
    LDS_WAIT();
    const int c = lane & 7;
#pragma unroll
    for (int j = 0; j < 4; ++j) { const int n = (lane >> 3) + 8 * j; const LAS float* s = scr + (8 * c) * 33 + n;
        v2u o; o.x = pk4_fp8(s[0 * 33] * wsc, s[1 * 33] * wsc, s[2 * 33] * wsc, s[3 * 33] * wsc); o.y = pk4_fp8(s[4 * 33] * wsc, s[5 * 33] * wsc, s[6 * 33] * wsc, s[7 * 33] * wsc);
        *(v2u*)(WT + (size_t)(dst_row + n) * K + k0 + 8 * c) = o; }
    LDS_WAIT();
}
__device__ __forceinline__ void p0_prologue(const Params& p, LAS unsigned char* lds) {
    const int tid = otid(p.wv), lane = tid & 63, wave = tid >> 6;
    unsigned char* ws = p.ws;
    LAS float* scr = (LAS float*)(lds + wave * 16384);
    const int gw = blockIdx.x * 8 + wave, NGW = gridDim.x * 8;
    constexpr int I_13 = 32 * 352, I_2 = 88 * 64, I_IN = 32 * 192, I_OUT = 32 * 64, I_RG = 64;
    constexpr int NITEMS = 2 * I_13 + 2 * I_2 + I_IN + I_OUT + 2 * I_RG;
    for (int it = gw; it < NITEMS; it += NGW) {
        int r = it;
        if (r < 2 * I_13) { const int which = r >= I_13; r -= which * I_13; const int kb = r / 352, nb = r % 352, n0 = 32 * nb, pt = n0 >> 8, rr = n0 & 255;
            const int sc = rr < 128 ? 128 * pt + rr : FF + 128 * pt + (rr - 128);
            if (which ? UP8_1 : UP8_0) tr_item8(kin(which ? I_F2W13 : I_F1W13), 2 * FF, D, sc, ws + (which ? WS_W13B : WS_W13A), n0, 64 * kb, scr, lane, FP8_WSCALE);
            else tr_item(kin(which ? I_F2W13 : I_F1W13), 2 * FF, D, sc, (bf16*)(ws + (which ? WS_W13B : WS_W13A)), n0, 64 * kb, scr, lane);
            continue; }
        r -= 2 * I_13;
        if (r < 2 * I_2) { const int which = r >= I_2; r -= which * I_2; const int kb = r >> 6, nb = r & 63;
            if (which ? DN8_1 : DN8_0) tr_item8(kin(which ? I_F2W2 : I_F1W2), D, FF, 32 * nb, ws + (which ? WS_W2B : WS_W2A), 32 * nb, 64 * kb, scr, lane, FP8_W2SCALE);
            else tr_item(kin(which ? I_F2W2 : I_F1W2), D, FF, 32 * nb, (bf16*)(ws + (which ? WS_W2B : WS_W2A)), 32 * nb, 64 * kb, scr, lane);
            continue; }
        r -= 2 * I_2;
        if (r < I_IN) { const int kb = r / 192, nb = r % 192, n0 = 32 * nb;
            tr_item(kin(I_WIN), INCOLS, D, n0 < 4096 ? n0 : n0 + 8, (bf16*)(ws + WS_WIN), n0, 64 * kb, scr, lane); continue; }
        r -= I_IN;
        if (r < I_OUT) { const int kb = r >> 6, nb = r & 63;
            tr_item(kin(I_WOUT), D, D, 32 * nb, (bf16*)(ws + WS_WOUT), 32 * nb, 64 * kb, scr, lane); continue; }
        r -= I_OUT;
        { const int which = r >= I_RG; r -= which * I_RG; const int blk = r >> 3, l = r & 7, kb = l >> 2, nb = l & 3;
            tr_item(kin(which ? I_WX : I_WA) + blk * 16384, 128, 128, 32 * nb, (bf16*)(ws + (which ? WS_WXT : WS_WAT)) + blk * 16384, 32 * nb, 64 * kb, scr, lane); }
    }
    __syncthreads();
    LAS float* sc = (LAS float*)lds;
    for (int i = tid; i < NBATCH * D; i += 512) { const float cv = kin(I_C)[i]; sc[i] = cv / (1.0f + __expf(-cv)); }
    __syncthreads();
    const int gid = blockIdx.x * 512 + tid;
    for (int it = gid; it < NKC * (NMOD / 4); it += gridDim.x * 512) {
        const int cgp = it % (NMOD / 4), kc = it / (NMOD / 4);
        const int k0 = 73 * kc + (kc < 4 ? kc : 4), klen = 73 + (kc < 4 ? 1 : 0);
        const f32x4* wp = (const f32x4*)(kin(I_WADA) + (size_t)k0 * NMOD) + cgp;
        f32x4 a0 = {0.f, 0.f, 0.f, 0.f}, a1 = {0.f, 0.f, 0.f, 0.f};
#pragma unroll 8
        for (int k = 0; k < klen; ++k) { const f32x4 w = __builtin_nontemporal_load(wp + (size_t)k * (NMOD / 4)); a0 += w * sc[k0 + k]; a1 += w * sc[D + k0 + k]; }
        if (kc == 0) { const f32x4 b4 = ((const f32x4*)kin(I_BADA))[cgp]; a0 += b4; a1 += b4; }
        f32x4* mp = (f32x4*)(ws + WS_MODP) + (size_t)kc * (2 * NMOD / 4) + cgp; mp[0] = a0; mp[NMOD / 4] = a1;
    }
    for (int it = gid; it < 8 * D; it += gridDim.x * 512) { const int g = it >> 11, k = it & 2047; ((float*)(ws + WS_WGT))[it] = kin(I_WIN)[(size_t)k * INCOLS + 4096 + g]; }
    __syncthreads();
}

constexpr int L_RP_G = 0, L_RP_B = 8192, L_RP_SC = 16384, L_RP_SH = 24576, L_RP_W = 32768, L_RP_GT = 98304;
__device__ __forceinline__ void row_pass(const Params& p, const void* src, bool src16  , float* dstx, int ln_idx  , int mod_idx  , bool do_gates, bool fp8out, bool from_partials, bool write_x, LAS unsigned char* lds) {
    const int tid = otid(p.wv), lane = tid & 63, wave = tid >> 6;
    const float* mod = (const float*)(p.ws + WS_MOD);
    bf16* U = (bf16*)(p.ws + WS_U);
    const int r0 = (int)(((long)blockIdx.x * M) / gridDim.x), r1 = (int)(((long)(blockIdx.x + 1) * M) / gridDim.x);
    LAS f32x4* Lg = (LAS f32x4*)(lds + L_RP_G); LAS f32x4* Lb = (LAS f32x4*)(lds + L_RP_B); LAS f32x4* Lsc = (LAS f32x4*)(lds + L_RP_SC); LAS f32x4* Lsh = (LAS f32x4*)(lds + L_RP_SH);
    LAS f32x4* Lw = (LAS f32x4*)(lds + L_RP_W);
    if (from_partials) {
        float* modw = (float*)(p.ws + WS_MOD); const float* pp = (const float*)(p.ws + WS_MODP);
        for (int i = blockIdx.x * 512 + tid; i < 2 * NMOD; i += gridDim.x * 512) { float s = 0.f;
#pragma unroll 4
            for (int kc = 0; kc < NKC; ++kc) s += pp[(size_t)kc * (2 * NMOD) + i];
            modw[i] = s; }
    }
    for (int b = 0; b < NBATCH; ++b) {
        const int s0 = r0 > b * SEQ ? r0 : b * SEQ, s1 = r1 < (b + 1) * SEQ ? r1 : (b + 1) * SEQ;
        if (s0 >= s1) continue;
        __syncthreads();
        if (ln_idx >= 0) { Lg[tid] = ((const f32x4*)(kin(I_LNG) + ln_idx * D))[tid]; Lb[tid] = ((const f32x4*)(kin(I_LNB) + ln_idx * D))[tid]; }
        if (mod_idx >= 0) {
            if (from_partials) { const f32x4* pp = (const f32x4*)(p.ws + WS_MODP) + ((size_t)b * NMOD + mod_idx * 3 * D) / 4 + tid; f32x4 sh = {0.f, 0.f, 0.f, 0.f}, sc = {0.f, 0.f, 0.f, 0.f};
#pragma unroll 4
                for (int kc = 0; kc < NKC; ++kc) { sh += pp[(size_t)kc * (2 * NMOD / 4)]; sc += pp[(size_t)kc * (2 * NMOD / 4) + D / 4]; }
                Lsh[tid] = sh; Lsc[tid] = sc + 1.0f;
            } else { const f32x4* mp = (const f32x4*)(mod + (size_t)b * NMOD + mod_idx * 3 * D); Lsh[tid] = mp[tid]; Lsc[tid] = mp[D / 4 + tid] + 1.0f; } }
        if (do_gates) { const f32x4* wg = (const f32x4*)(p.ws + WS_WGT);
#pragma unroll
            for (int g = 0; g < 8; ++g) Lw[g * 512 + tid] = wg[g * 512 + tid]; }
        __syncthreads();
        int m = s0 + wave;
        typedef _Float16 f16x4 __attribute__((ext_vector_type(4)));
        f32x4 nx[8]; f16x4 nh[8];
        const bool last_use = (mod_idx < 0);
#define RP_LOAD(row_) do { if (src16) { const f16x4* xr_ = (const f16x4*)((const bf16*)src + (size_t)(row_) * D) + lane; \
            if (last_use) { _Pragma("unroll") for (int j = 0; j < 8; ++j) nh[j] = __builtin_nontemporal_load(xr_ + 64 * j); } \
            else { _Pragma("unroll") for (int j = 0; j < 8; ++j) nh[j] = xr_[64 * j]; } } \
        else { const f32x4* xr_ = (const f32x4*)((const float*)src + (size_t)(row_) * D) + lane; _Pragma("unroll") for (int j = 0; j < 8; ++j) nx[j] = __builtin_nontemporal_load(xr_ + 64 * j); } } while (0)
        if (m < s1) RP_LOAD(m);
        for (; m < s1; m += 8) {
            f32x4 v[8]; f32x4 s4 = {0.f, 0.f, 0.f, 0.f};
#pragma unroll
            for (int j = 0; j < 8; ++j) { v[j] = src16 ? __builtin_convertvector(nh[j], f32x4) : nx[j]; s4 += v[j]; }
            if (m + 8 < s1) RP_LOAD(m + 8);
            float mean = wave_sum((s4.x + s4.y) + (s4.z + s4.w), lane) * (1.f / D); f32x4 q4 = {0.f, 0.f, 0.f, 0.f};
#pragma unroll
            for (int j = 0; j < 8; ++j) { v[j] = v[j] - mean; q4 += v[j] * v[j]; }
            float rstd = 1.0f / sqrtf(wave_sum((q4.x + q4.y) + (q4.z + q4.w), lane) * (1.f / D) + LN_EPS);
            if (ln_idx >= 0) {
                f32x4* xo = (f32x4*)(dstx + (size_t)m * D) + lane; s4 = (f32x4){0.f, 0.f, 0.f, 0.f};
#pragma unroll
                for (int j = 0; j < 8; ++j) { v[j] = (v[j] * rstd) * Lg[lane + 64 * j] + Lb[lane + 64 * j]; if (write_x) { if (last_use) __builtin_nontemporal_store(v[j], xo + 64 * j); else xo[64 * j] = v[j]; } s4 += v[j]; }
                if (!write_x && lane == 0) { float* st = (float*)(p.ws + WS_STAT) + 2 * (size_t)m; st[0] = mean; st[1] = rstd; }
                if (mod_idx < 0) continue;
                mean = wave_sum((s4.x + s4.y) + (s4.z + s4.w), lane) * (1.f / D); q4 = (f32x4){0.f, 0.f, 0.f, 0.f};
#pragma unroll
                for (int j = 0; j < 8; ++j) { v[j] = v[j] - mean; q4 += v[j] * v[j]; }
                rstd = 1.0f / sqrtf(wave_sum((q4.x + q4.y) + (q4.z + q4.w), lane) * (1.f / D) + LN_EPS);
            }
            if (fp8out) { unsigned* uo8 = (unsigned*)((unsigned char*)U + (size_t)m * D) + lane;
                const float rs = rstd * FP8_ASCALE;
#pragma unroll
                for (int j = 0; j < 8; ++j) { v[j] = (v[j] * rs) * Lsc[lane + 64 * j] + Lsh[lane + 64 * j] * FP8_ASCALE; uo8[64 * j] = pk4_fp8(v[j].x, v[j].y, v[j].z, v[j].w); }
            } else { v2u* uo = (v2u*)(U + (size_t)m * D) + lane;
#pragma unroll
                for (int j = 0; j < 8; ++j) { v[j] = (v[j] * rstd) * Lsc[lane + 64 * j] + Lsh[lane + 64 * j]; v2u w; w.x = pk2(v[j].x, v[j].y); w.y = pk2(v[j].z, v[j].w); uo[64 * j] = w; } }
            if (do_gates) {
                float d[8];
#pragma unroll
                for (int g = 0; g < 8; ++g) { f32x4 d4 = {0.f, 0.f, 0.f, 0.f};
#pragma unroll
                    for (int j = 0; j < 8; ++j) d4 += v[j] * Lw[g * 512 + lane + 64 * j];
                    d[g] = (d4.x + d4.y) + (d4.z + d4.w);
                    asm volatile("" ::: "memory"); }
                float e4[4], e2[2], e1;
                const bool h32 = lane & 32, h16 = lane & 16, h8 = lane & 8;
#pragma unroll
                for (int k = 0; k < 4; ++k) { const float keep = h32 ? d[k + 4] : d[k], send = h32 ? d[k] : d[k + 4]; e4[k] = keep + shx(send, 32, lane); }
#pragma unroll
                for (int k = 0; k < 2; ++k) { const float keep = h16 ? e4[k + 2] : e4[k], send = h16 ? e4[k] : e4[k + 2]; e2[k] = keep + shx(send, 16, lane); }
                { const float keep = h8 ? e2[1] : e2[0], send = h8 ? e2[0] : e2[1]; e1 = keep + shx(send, 8, lane); }
                e1 += shx(e1, 4, lane); e1 += shx(e1, 2, lane); e1 += shx(e1, 1, lane);
                if ((lane & 7) == 0) { const int g = (lane >> 3); const float gv = e1 + kin(I_BIN)[4096 + g]; ((float*)(p.ws + WS_GATES))[(size_t)m * 8 + g] = gv; ((LAS float*)(lds + L_RP_GT))[((m - s0) & 63) * 8 + g] = gv; }
            }
        }
        if (do_gates) {
            __syncthreads();
            if (tid < NH) { const LAS float* gt = (const LAS float*)(lds + L_RP_GT); float A = 0.f, B = -__builtin_inff();
                for (int t = 0; t < 64; ++t) { const float li = gt[t * 8 + tid], lf = logsigm(gt[t * 8 + 4 + tid]); B = fmaxf(B + lf, li); A += lf; }
                float* qp = (float*)(p.ws + WS_QP) + ((size_t)(s0 >> 6) * NH + tid) * 2; qp[0] = A; qp[1] = B; }
        }
    }
    __syncthreads();
}
constexpr int KV_BUF = 34816;
constexpr int KT_PITCH = 528, VT_PITCH = 560, KV_VOFF = 16896;
constexpr int CT_BUF = 50688;
constexpr int L_GB = 104448, L_GLI = L_GB + 1024, L_GM = L_GB + 2048, L_GW = L_GB + 3072, L_MISC = L_GB + 4096;

__device__ __forceinline__ void mlstm_gates(const float* __restrict__ gates, const float* __restrict__ qp, int b, int h, int j, LAS unsigned char* lds, int wv) {
    const int tid = otid(wv), lane = tid & 63, wave = tid >> 6;
    LAS float* GB = (LAS float*)(lds + L_GB); LAS float* GLI = (LAS float*)(lds + L_GLI); LAS float* GM = (LAS float*)(lds + L_GM); LAS float* MISC = (LAS float*)(lds + L_MISC);
    const float NEG = -__builtin_inff();
    if (wave == 0) {
        float A = 0.f, B = NEG;
#pragma unroll
        for (int i = 0; i < 2; ++i) { const int qi = 2 * lane + i; if (qi < 4 * j) { const float a = qp[((size_t)(b * 128 + qi) * NH + h) * 2], bb = qp[((size_t)(b * 128 + qi) * NH + h) * 2 + 1]; B = fmaxf(B + a, bb); A += a; } }
#pragma unroll
        for (int o = 1; o < 64; o <<= 1) { const float Ap = shup(A, o, lane), Bp = shup(B, o, lane); if (lane >= o) { B = fmaxf(Bp + A, B); A = Ap + A; } }
        const float mend = fmaxf(A, B);
        float ms = shfrom(mend, (2 * j - 1) & 63); if (j == 0) ms = 0.f;
        const float* gp = gates + ((size_t)b * SEQ + SC * j + 4 * lane) * 8;
        float li[4], lf[4], cs[4];
#pragma unroll
        for (int i = 0; i < 4; ++i) { li[i] = gp[i * 8 + h]; lf[i] = logsigm(gp[i * 8 + 4 + h]); }
        cs[0] = lf[0]; cs[1] = cs[0] + lf[1]; cs[2] = cs[1] + lf[2]; cs[3] = cs[2] + lf[3];
        float incl = cs[3];
#pragma unroll
        for (int o = 1; o < 64; o <<= 1) { const float t = shup(incl, o, lane); if (lane >= o) incl += t; }
        const float excl = incl - cs[3];
        float LA = cs[3], LB = NEG;
#pragma unroll
        for (int i = 0; i < 4; ++i) LB = fmaxf(LB + lf[i], li[i]);
#pragma unroll
        for (int o = 1; o < 64; o <<= 1) { const float Ap = shup(LA, o, lane), Bp = shup(LB, o, lane); if (lane >= o) { LB = fmaxf(Bp + LA, LB); LA = Ap + LA; } }
        const float Ae = shup(LA, 1, lane), Be = shup(LB, 1, lane);
        float mp = (lane == 0) ? ms : fmaxf(ms + Ae, Be);
#pragma unroll
        for (int i = 0; i < 4; ++i) { mp = fmaxf(mp + lf[i], li[i]); GB[4 * lane + i] = excl + cs[i]; GLI[4 * lane + i] = li[i]; GM[4 * lane + i] = mp; }
        if (lane == 0) MISC[0] = ms;
    }
    LDS_BARRIER();
}
#define KV_LOAD(blk) do { int t_ = tid; asm volatile("" : "+v"(t_)); _Pragma("unroll") for (int i_ = 0; i_ < 2; ++i_) { const int c_ = t_ + 512 * i_, r_ = c_ >> 5, ch_ = c_ & 31; \
        rk[i_] = *(const v4u*)(Kp + (size_t)(32 * (blk) + r_) * DR + 8 * ch_); rv[i_] = *(const v4u*)(Vp + (size_t)(32 * (blk) + r_) * DR + 8 * ch_); } } while (0)
#define KV_STORE(buf) do { int t_ = tid; asm volatile("" : "+v"(t_)); _Pragma("unroll") for (int i_ = 0; i_ < 2; ++i_) { const int c_ = t_ + 512 * i_, r_ = c_ >> 5, ch_ = c_ & 31; \
        *(LAS v4u*)(lds + (buf) * KV_BUF + r_ * KT_PITCH + 16 * ch_) = rk[i_]; *(LAS v4u*)(lds + (buf) * KV_BUF + KV_VOFF + r_ * VT_PITCH + 16 * ch_) = rv[i_]; } } while (0)
__device__ __forceinline__ void preset_ones_col(LAS unsigned char* lds, int tid) {
    if (tid < 128) { const int bf = tid >> 6, r = (tid >> 1) & 31, hf = tid & 1; v4u z = {0u, 0u, 0u, 0u}; if (!hf) z.x = 0x3F80u; *(LAS v4u*)(lds + bf * KV_BUF + KV_VOFF + r * VT_PITCH + 512 + 16 * hf) = z; }
}
__device__ __forceinline__ bf16x8 scale8(bf16x8 x, f32x4 wl, f32x4 wh) {
    const v4u u = __builtin_bit_cast(v4u, x); v4u o;
    o.x = pk2(bflo(u.x) * wl.x, bfhi(u.x) * wl.y); o.y = pk2(bflo(u.y) * wl.z, bfhi(u.y) * wl.w); o.z = pk2(bflo(u.z) * wh.x, bfhi(u.z) * wh.y); o.w = pk2(bflo(u.w) * wh.z, bfhi(u.w) * wh.w);
    return __builtin_bit_cast(bf16x8, o);
}
__device__ __forceinline__ void m1_unit(const Params& p, int bh, int j, LAS unsigned char* lds) {
    const int tid = otid(p.wv), lane = tid & 63, wave = tid >> 6, b = bh >> 2, h = bh & 3;
    LAS float* GB = (LAS float*)(lds + L_GB); LAS float* GLI = (LAS float*)(lds + L_GLI); LAS float* GM = (LAS float*)(lds + L_GM); LAS float* GW = (LAS float*)(lds + L_GW);
    LAS float* MISC = (LAS float*)(lds + L_MISC);
    const bf16* Kp = (const bf16*)(p.ws + WS_PROJ) + (size_t)1 * M * DR + ((size_t)b * SEQ + SC * j) * DR + h * DH;
    const bf16* Vp = (const bf16*)(p.ws + WS_PROJ) + (size_t)2 * M * DR + ((size_t)b * SEQ + SC * j) * DR + h * DH;
    v4u rk[2], rv[2];
    KV_LOAD(0);
    mlstm_gates((const float*)(p.ws + WS_GATES), (const float*)(p.ws + WS_QP), b, h, j, lds, p.wv);
    const float b_last = GB[SC - 1], m_end = GM[SC - 1], m_start = MISC[0];
    if (tid < SC) GW[tid] = __expf(b_last - GB[tid] + GLI[tid] - m_end) * 0.0625f;
    if (tid == 0) ((float*)(p.ws + WS_MDEC))[bh * NSC + j] = __expf(b_last + m_start - m_end);
    preset_ones_col(lds, tid);
    KV_STORE(0); KV_LOAD(1);
    LDS_BARRIER();
    f32x4 acc[17][2];
#pragma unroll
    for (int mt = 0; mt < 17; ++mt) { acc[mt][0] = (f32x4){0.f, 0.f, 0.f, 0.f}; acc[mt][1] = (f32x4){0.f, 0.f, 0.f, 0.f}; }
#pragma unroll 1
    for (int sb = 0; sb < 8; ++sb) {
        int g = lane >> 4, q = (lane & 15) >> 2, pp = lane & 3; asm volatile("" : "+v"(g), "+v"(q), "+v"(pp));
        LAS unsigned char* buf = lds + (sb & 1) * KV_BUF;
        {
            const int rowoff = 8 * g + q;
            LAS unsigned char* kb = buf + rowoff * KT_PITCH + (32 * wave + 4 * pp) * 2;
            const f32x4 wl = *(const LAS f32x4*)(GW + 32 * sb + 8 * g), wh = *(const LAS f32x4*)(GW + 32 * sb + 8 * g + 4);
            const bf16x8 b0 = scale8(cat8(tr_read(kb), tr_read(kb + 4 * KT_PITCH)), wl, wh), b1 = scale8(cat8(tr_read(kb + 32), tr_read(kb + 32 + 4 * KT_PITCH)), wl, wh);
            LAS unsigned char* vb = buf + KV_VOFF + rowoff * VT_PITCH + (4 * pp) * 2;
#pragma unroll
            for (int mt = 0; mt < 17; ++mt) { const bf16x8 a = cat8(tr_read(vb + 32 * mt), tr_read(vb + 32 * mt + 4 * VT_PITCH));
                acc[mt][0] = MFMA16(a, b0, acc[mt][0]); acc[mt][1] = MFMA16(a, b1, acc[mt][1]); if ((mt & 3) == 3) asm volatile("" ::: "memory"); }
        }
        if (sb + 1 < 8) KV_STORE((sb + 1) & 1);
        if (sb + 2 < 8) KV_LOAD(sb + 2);
        LDS_BARRIER();
    }
    float* dc = (float*)(p.ws + WS_DC) + (size_t)(bh * NSC + j) * CROWS * DH;
#pragma unroll
    for (int mt = 0; mt < 17; ++mt) {
        int ro = (4 * (lane >> 4)) * DH + 32 * wave + (lane & 15); asm volatile("" : "+v"(ro));
        float* dp = dc + (size_t)(16 * mt) * DH + ro;
#pragma unroll
        for (int nl = 0; nl < 2; ++nl)
#pragma unroll
            for (int i = 0; i < 4; ++i) dp[i * DH + 16 * nl] = acc[mt][nl][i]; }
}
__device__ __forceinline__ void m2_scan(const Params& p) {
    const float* __restrict__ dc = (const float*)(p.ws + WS_DC); bf16* __restrict__ cb = (bf16*)(p.ws + WS_CB); const float* __restrict__ dec = (const float*)(p.ws + WS_MDEC);
    constexpr int PER = CROWS * DH / 4;
    const int nthr = gridDim.x * 512;
    for (int it = blockIdx.x * 512 + otid(p.wv); it < 8 * PER; it += 2 * nthr) {
        const bool two = it + nthr < 8 * PER; const int it1 = two ? it + nthr : it;
        const int bh0 = it / PER, idx0 = it % PER, bh1 = it1 / PER, idx1 = it1 % PER;
        const f32x4* src0 = (const f32x4*)(dc + (size_t)bh0 * NSC * CROWS * DH) + idx0; v2u* dst0 = (v2u*)(cb + (size_t)bh0 * NSC * CROWS * DH) + idx0;
        const f32x4* src1 = (const f32x4*)(dc + (size_t)bh1 * NSC * CROWS * DH) + idx1; v2u* dst1 = (v2u*)(cb + (size_t)bh1 * NSC * CROWS * DH) + idx1;
        f32x4 C0 = {0.f, 0.f, 0.f, 0.f}, C1 = {0.f, 0.f, 0.f, 0.f};
#pragma unroll 8
        for (int j = 0; j < NSC; ++j) {
            const f32x4 d0 = __builtin_nontemporal_load(src0 + (size_t)j * PER), d1 = __builtin_nontemporal_load(src1 + (size_t)j * PER);
            v2u w; w.x = pk2(C0.x, C0.y); w.y = pk2(C0.z, C0.w); dst0[(size_t)j * PER] = w;
            if (two) { v2u w1; w1.x = pk2(C1.x, C1.y); w1.y = pk2(C1.z, C1.w); dst1[(size_t)j * PER] = w1; }
            C0 = C0 * dec[bh0 * NSC + j] + d0; C1 = C1 * dec[bh1 * NSC + j] + d1; }
    }
}
#define CT_LOAD(row0, npc) do { int t_ = tid; asm volatile("" : "+v"(t_)); _Pragma("unroll") for (int i_ = 0; i_ < (npc); ++i_) rc[i_] = *(const v4u*)(cb + (size_t)(row0) * DH + (size_t)(t_ + 512 * i_) * 8); } while (0)
#define CT_STORE(buf, npc) do { int t_ = tid; asm volatile("" : "+v"(t_)); _Pragma("unroll") for (int i_ = 0; i_ < (npc); ++i_) { const int c_ = t_ + 512 * i_, r_ = c_ >> 5, ch_ = c_ & 31; *(LAS v4u*)(lds + (buf) * CT_BUF + r_ * KT_PITCH + 16 * ch_) = rc[i_]; } } while (0)
#define CT_MMA(buf, MT0, MT1) do { _Pragma("unroll") for (int mt = (MT0); mt < (MT1); ++mt) { \
        LAS unsigned char* ap_ = lds + (buf) * CT_BUF + (16 * (mt - (MT0)) + l15) * KT_PITCH + 16 * g; \
        _Pragma("unroll") for (int ks = 0; ks < 8; ++ks) acc[mt] = MFMA16(*(const LAS bf16x8*)(ap_ + 64 * ks), bq[ks], acc[mt]); \
        if ((mt - (MT0)) & 1) asm volatile("" ::: "memory"); } } while (0)
__device__ __forceinline__ void m3_unit(const Params& p, int bh, int j, LAS unsigned char* lds) {
    const int tid = otid(p.wv), lane = tid & 63, wave = tid >> 6, b = bh >> 2, h = bh & 3;
    LAS float* GB = (LAS float*)(lds + L_GB); LAS float* GLI = (LAS float*)(lds + L_GLI); LAS float* GM = (LAS float*)(lds + L_GM); LAS float* MISC = (LAS float*)(lds + L_MISC);
    const size_t tokbase = (size_t)b * SEQ + SC * j;
    const bf16* Qp = (const bf16*)(p.ws + WS_PROJ) + tokbase * DR + h * DH;
    const bf16* Kp = (const bf16*)(p.ws + WS_PROJ) + (size_t)1 * M * DR + tokbase * DR + h * DH;
    const bf16* Vp = (const bf16*)(p.ws + WS_PROJ) + (size_t)2 * M * DR + tokbase * DR + h * DH;
    const bf16* Op = (const bf16*)(p.ws + WS_PROJ) + (size_t)3 * M * DR + tokbase * DR + h * DH;
    const bf16* cb = (const bf16*)(p.ws + WS_CB) + (size_t)(bh * NSC + j) * CROWS * DH;
    bf16* Y = (bf16*)(p.ws + WS_U) + tokbase * D + h * DH;
    const float* ng = kin(I_MNG) + h * DH;
    v4u rc[6];
    CT_LOAD(0, 6);
    mlstm_gates((const float*)(p.ws + WS_GATES), (const float*)(p.ws + WS_QP), b, h, j, lds, p.wv);
    const float m_start = MISC[0];
#pragma unroll 1
    for (int ps = 0; ps < 2; ++ps) {
        int l15 = lane & 15, g = lane >> 4, pp = lane & 3; asm volatile("" : "+v"(l15), "+v"(g), "+v"(pp));
        const int q = l15 >> 2;
        const int t0 = 128 * ps + 16 * wave, tl = t0 + l15;
        bf16x8 bq[8];
#pragma unroll
        for (int ks = 0; ks < 8; ++ks) bq[ks] = *(const bf16x8*)(Qp + (size_t)tl * DR + 32 * ks + 8 * g);
        f32x4 acc[17];
#pragma unroll
        for (int mt = 0; mt < 17; ++mt) acc[mt] = (f32x4){0.f, 0.f, 0.f, 0.f};
        CT_STORE(0, 6); CT_LOAD(96, 6);
        LDS_BARRIER();
        CT_MMA(0, 0, 6);
        CT_STORE(1, 6); CT_LOAD(192, 5);
        LDS_BARRIER();
        CT_MMA(1, 6, 12);
        CT_STORE(0, 5);
        LDS_BARRIER();
        CT_MMA(0, 12, 17);
        v4u rk[2], rv[2];
        KV_LOAD(0);
        const float bt = GB[tl], mt_ = GM[tl];
        const float winter = __expf(bt + m_start - mt_);
#pragma unroll
        for (int mt = 0; mt < 17; ++mt) acc[mt] = acc[mt] * winter;
        LDS_BARRIER();
        const int nblk = 4 * ps + 4;
        preset_ones_col(lds, tid);
        KV_STORE(0); KV_LOAD(1);
        LDS_BARRIER();
#pragma unroll 1
        for (int kb = 0; kb < nblk; ++kb) {
            const int s0 = 32 * kb;
            if (s0 <= t0 + 15) {
                LAS unsigned char* buf = lds + (kb & 1) * KV_BUF;
                f32x4 sa = {0.f, 0.f, 0.f, 0.f}, sb = {0.f, 0.f, 0.f, 0.f};
                LAS unsigned char* kr = buf + l15 * KT_PITCH + 16 * g;
#pragma unroll
                for (int ks = 0; ks < 8; ++ks) { const bf16x8 ka = *(const LAS bf16x8*)(kr + 64 * ks), kb2 = *(const LAS bf16x8*)(kr + 16 * KT_PITCH + 64 * ks);
                    sa = MFMA16(ka, bq[ks], sa); sb = MFMA16(kb2, bq[ks], sb); }
                float pa[4], pb[4];
#pragma unroll
                for (int i = 0; i < 4; ++i) { const int s1 = s0 + 4 * g + i, s2 = s1 + 16;
                    const float w1 = (s1 <= tl) ? __expf(bt - GB[s1] + GLI[s1] - mt_) * 0.0625f : 0.f;
                    const float w2 = (s2 <= tl) ? __expf(bt - GB[s2] + GLI[s2] - mt_) * 0.0625f : 0.f;
                    pa[i] = sa[i] * w1; pb[i] = sb[i] * w2; }
                v4u pw; pw.x = pk2(pa[0], pa[1]); pw.y = pk2(pa[2], pa[3]); pw.z = pk2(pb[0], pb[1]); pw.w = pk2(pb[2], pb[3]);
                const bf16x8 pf = __builtin_bit_cast(bf16x8, pw);
                LAS unsigned char* vb = buf + KV_VOFF + (4 * g + q) * VT_PITCH + (4 * pp) * 2;
#pragma unroll
                for (int mt = 0; mt < 17; ++mt) { const bf16x8 a = cat8(tr_read(vb + 32 * mt), tr_read(vb + 32 * mt + 16 * VT_PITCH)); acc[mt] = MFMA16(a, pf, acc[mt]); if ((mt & 3) == 3) asm volatile("" ::: "memory"); }
            }
            if (kb + 1 < nblk) KV_STORE((kb + 1) & 1);
            if (kb + 2 < nblk) KV_LOAD(kb + 2);
            LDS_BARRIER();
        }
        if (ps == 0) CT_LOAD(0, 6);
        const float den = shfrom(acc[16][0], l15);
        const float inv = 1.0f / fmaxf(fabsf(den), __expf(-mt_));
        float s = 0.f;
#pragma unroll
        for (int mt = 0; mt < 16; ++mt) { acc[mt] = acc[mt] * inv; s += (acc[mt][0] + acc[mt][1]) + (acc[mt][2] + acc[mt][3]); }
        s += shx(s, 16, lane); s += shx(s, 32, lane);
        const float mean = s * (1.f / DH); float s2 = 0.f;
#pragma unroll
        for (int mt = 0; mt < 16; ++mt) { acc[mt] = acc[mt] - mean; s2 += (acc[mt][0] * acc[mt][0] + acc[mt][1] * acc[mt][1]) + (acc[mt][2] * acc[mt][2] + acc[mt][3] * acc[mt][3]); }
        s2 += shx(s2, 16, lane); s2 += shx(s2, 32, lane);
        const float rstd = 1.0f / sqrtf(s2 * (1.f / DH) + LN_EPS);
#pragma unroll
        for (int mt = 0; mt < 16; ++mt) { const int e = 16 * mt + 4 * g;
            const f32x4 g4 = *(const f32x4*)(ng + e); const v2u o2 = *(const v2u*)(Op + (size_t)tl * DR + e);
            const float y0 = acc[mt][0] * rstd * g4.x * sigm(bflo(o2.x)), y1 = acc[mt][1] * rstd * g4.y * sigm(bfhi(o2.x));
            const float y2 = acc[mt][2] * rstd * g4.z * sigm(bflo(o2.y)), y3 = acc[mt][3] * rstd * g4.w * sigm(bfhi(o2.y));
            v2u w; w.x = pk2(y0, y1); w.y = pk2(y2, y3); *(v2u*)(Y + (size_t)tl * D + e) = w; }
    }
    LDS_BARRIER();
}

constexpr int RG_XC = 0, XC_PITCH = 272, XC_BUF = 17408;
constexpr int RG_CW = 34816;
constexpr int RG_HS = 37888, HS_PITCH = 132;
__device__ __forceinline__ float gelu_tanh(float x) { return x * sigm(x * (1.5957691216057308f + 0.07135481283f * x * x)); }
#define RG_LOADX(tile_) do { const int tok_ = (tile_) * 64 + tt, tsq_ = tok_ & (SEQ - 1); _Pragma("unroll") for (int tap = 0; tap < 4; ++tap) { \
        const int row_ = (tsq_ - 3 + tap >= 0) ? tok_ - 3 + tap : tok_; const bf16* xp_ = XR + (size_t)row_ * DR + blk * 128 + 16 * c8; xr[tap][0] = *(const v4u*)xp_; xr[tap][1] = *(const v4u*)(xp_ + 8); } } while (0)
__device__ __forceinline__ void rg_phase(const Params& p, int pass, LAS unsigned char* lds) {
    const int tid = otid(p.wv), lane = tid & 63, wave = tid >> 6, g = lane >> 4, l15 = lane & 15;
    const bf16* XR = (const bf16*)(p.ws + WS_PROJ) + (size_t)4 * M * DR; const bf16* GR = (const bf16*)(p.ws + WS_PROJ) + (size_t)5 * M * DR;
    const int blk = blockIdx.x & 7, tstep = gridDim.x >> 3, tt = tid >> 3, c8 = tid & 7;
    LAS float* CW = (LAS float*)(lds + RG_CW); LAS float* HS = (LAS float*)(lds + RG_HS);
    { const int tap = tid >> 7, c = tid & 127; CW[tid] = kin(I_CONVW)[tap * DR + blk * 128 + c]; if (tid < 128) CW[512 + tid] = kin(I_CONVB)[blk * 128 + tid]; }
    bf16x8 fa[4], fx[4];
    { const bf16* wa = (const bf16*)(p.ws + WS_WAT) + blk * 16384 + (16 * wave + l15) * 128 + 8 * g;
      const bf16* wx = (const bf16*)(p.ws + WS_WXT) + blk * 16384 + (16 * wave + l15) * 128 + 8 * g;
#pragma unroll
      for (int ks = 0; ks < 4; ++ks) { fa[ks] = *(const bf16x8*)(wa + 32 * ks); fx[ks] = *(const bf16x8*)(wx + 32 * ks); } }
    const int c = 16 * wave + l15, ch = blk * 128 + c;
    const float bav = kin(I_BA)[ch], bxv = kin(I_BX)[ch], sp8 = 8.0f * log1pf(__expf(-kin(I_LAM)[ch]));
    v4u xr[4][2], gq[2];
    int tile = blockIdx.x >> 3;
    if (tile < M / 64) RG_LOADX(tile);
    LDS_BARRIER();
#pragma unroll 1
    for (int it = 0; tile < M / 64; tile += tstep, ++it) {
        const int tok = tile * 64 + tt, tseq = tok & (SEQ - 1);
        LAS unsigned char* xc = lds + RG_XC + (it & 1) * XC_BUF;
#pragma unroll
        for (int hf = 0; hf < 2; ++hf) { float a[8];
            { const f32x4 b0 = *(const LAS f32x4*)(CW + 512 + 16 * c8 + 8 * hf), b1 = *(const LAS f32x4*)(CW + 512 + 16 * c8 + 8 * hf + 4); a[0] = b0.x; a[1] = b0.y; a[2] = b0.z; a[3] = b0.w; a[4] = b1.x; a[5] = b1.y; a[6] = b1.z; a[7] = b1.w; }
#pragma unroll
            for (int tap = 0; tap < 4; ++tap) { const float vm = (tseq - 3 + tap >= 0) ? 1.0f : 0.0f; const v4u x = xr[tap][hf];
                const f32x4 w0 = *(const LAS f32x4*)(CW + tap * 128 + 16 * c8 + 8 * hf) * vm, w1 = *(const LAS f32x4*)(CW + tap * 128 + 16 * c8 + 8 * hf + 4) * vm;
                a[0] += bflo(x.x) * w0.x; a[1] += bfhi(x.x) * w0.y; a[2] += bflo(x.y) * w0.z; a[3] += bfhi(x.y) * w0.w;
                a[4] += bflo(x.z) * w1.x; a[5] += bfhi(x.z) * w1.y; a[6] += bflo(x.w) * w1.z; a[7] += bfhi(x.w) * w1.w; }
            v4u o; o.x = pk2(a[0], a[1]); o.y = pk2(a[2], a[3]); o.z = pk2(a[4], a[5]); o.w = pk2(a[6], a[7]);
            *(LAS v4u*)(xc + tt * XC_PITCH + (16 * c8 + 8 * hf) * 2) = o; }
        float carry = (pass == 1) ? ((const float*)(p.ws + WS_RGC))[(size_t)tile * DR + ch] : 0.f;
        if (pass == 1) { const bf16* gp = GR + (size_t)tok * DR + blk * 128 + 16 * c8; gq[0] = *(const v4u*)gp; gq[1] = *(const v4u*)(gp + 8); }
        asm volatile("" ::: "memory");
        { const int nt_ = (tile + tstep < M / 64) ? tile + tstep : tile; RG_LOADX(nt_); }
        LDS_BARRIER();
        f32x4 ar[4], ai[4];
#pragma unroll
        for (int mt = 0; mt < 4; ++mt) { ar[mt] = (f32x4){0.f, 0.f, 0.f, 0.f}; ai[mt] = (f32x4){0.f, 0.f, 0.f, 0.f};
#pragma unroll
            for (int ks = 0; ks < 4; ++ks) { const bf16x8 a = *(const LAS bf16x8*)(xc + (16 * mt + l15) * XC_PITCH + 64 * ks + 16 * g);
                ar[mt] = MFMA16(a, fa[ks], ar[mt]); ai[mt] = MFMA16(a, fx[ks], ai[mt]); } }
        float Ptot = 1.f;
#pragma unroll
        for (int mt = 0; mt < 4; ++mt) {
            float av[4], uv[4];
            {
                const f32x4 er4 = (ar[mt] + bav) * -1.4426950408889634f, ei4 = (ai[mt] + bxv) * -1.4426950408889634f; f32x4 dr, di;
#pragma unroll
                for (int i = 0; i < 4; ++i) { dr[i] = __builtin_amdgcn_exp2f(er4[i]); di[i] = __builtin_amdgcn_exp2f(ei4[i]); }
                dr = dr + 1.0f; di = di + 1.0f; f32x4 r4, ig4;
#pragma unroll
                for (int i = 0; i < 4; ++i) { r4[i] = __builtin_amdgcn_rcpf(dr[i]); ig4[i] = __builtin_amdgcn_rcpf(di[i]); }
                const f32x4 la4 = r4 * -sp8, ea4 = la4 * 1.4426950408889634f, t2 = la4 * 2.0f; f32x4 a4;
#pragma unroll
                for (int i = 0; i < 4; ++i) a4[i] = __builtin_amdgcn_exp2f(ea4[i]);
                const f32x4 om = -t2 * (t2 * (t2 * (t2 * (t2 * 0.008333334f + 0.041666668f) + 0.16666667f) + 0.5f) + 1.0f), dm = 1.0f - a4 * a4; f32x4 xc4;
#pragma unroll
                for (int i = 0; i < 4; ++i) xc4[i] = __builtin_bit_cast(float, (unsigned)(*(const LAS unsigned short*)(xc + (16 * mt + 4 * g + i) * XC_PITCH + 2 * c)) << 16);
                const f32x4 gx = ig4 * xc4;
#pragma unroll
                for (int i = 0; i < 4; ++i) { av[i] = a4[i]; uv[i] = __builtin_amdgcn_sqrtf(t2[i] > -0.5f ? om[i] : dm[i]) * gx[i]; }
            }
            float P = (av[0] * av[1]) * (av[2] * av[3]), H = ((uv[0] * av[1] + uv[1]) * av[2] + uv[2]) * av[3] + uv[3];
            { const float Pp = shup(P, 16, lane), Hp = shup(H, 16, lane); if (g >= 1) { H = P * Hp + H; P = P * Pp; } }
            { const float Pp = shup(P, 32, lane), Hp = shup(H, 32, lane); if (g >= 2) { H = P * Hp + H; P = P * Pp; } }
            float Pe = shup(P, 16, lane), He = shup(H, 16, lane); if (g == 0) { Pe = 1.f; He = 0.f; }
            const float P3 = shfrom(P, l15 + 48), H3 = shfrom(H, l15 + 48);
            if (pass == 1) { float hh = Pe * carry + He;
#pragma unroll
                for (int i = 0; i < 4; ++i) { hh = av[i] * hh + uv[i]; HS[(16 * mt + 4 * g + i) * HS_PITCH + c] = hh; } }
            carry = P3 * carry + H3; Ptot *= P3;
        }
        if (pass == 0) { if (g == 0) { ((float*)(p.ws + WS_RGP))[(size_t)tile * DR + ch] = Ptot; ((float*)(p.ws + WS_RGH))[(size_t)tile * DR + ch] = carry; } }
        else {
            LDS_BARRIER();
            bf16* Y = (bf16*)(p.ws + WS_U) + (size_t)tok * D + DR + blk * 128 + 16 * c8;
#pragma unroll
            for (int hf = 0; hf < 2; ++hf) { const v4u gv = gq[hf];
                const LAS float* hp = HS + tt * HS_PITCH + 16 * c8 + 8 * hf; const f32x4 h0 = *(const LAS f32x4*)hp, h1 = *(const LAS f32x4*)(hp + 4);
                v4u o; o.x = pk2(h0.x * gelu_tanh(bflo(gv.x)), h0.y * gelu_tanh(bfhi(gv.x))); o.y = pk2(h0.z * gelu_tanh(bflo(gv.y)), h0.w * gelu_tanh(bfhi(gv.y)));
                o.z = pk2(h1.x * gelu_tanh(bflo(gv.z)), h1.y * gelu_tanh(bfhi(gv.z))); o.w = pk2(h1.z * gelu_tanh(bflo(gv.w)), h1.w * gelu_tanh(bfhi(gv.w)));
                *(v4u*)(Y + 8 * hf) = o; }
        }
    }
    LDS_BARRIER();
}
__device__ __forceinline__ void rg_carry_unit(const Params& p, int unit, LAS unsigned char* lds) {
    const int tid = otid(p.wv), b = unit >> 4, cg0 = (unit & 15) * 64;
    LAS float* Pl = (LAS float*)lds; LAS float* Hl = (LAS float*)(lds + 32768);
    const float* RP = (const float*)(p.ws + WS_RGP); const float* RH = (const float*)(p.ws + WS_RGH); float* RC = (float*)(p.ws + WS_RGC);
    for (int i = tid; i < 128 * 64; i += 512) { const int tl = i >> 6, c = i & 63; const size_t o = (size_t)(b * 128 + tl) * DR + cg0 + c; Pl[i] = RP[o]; Hl[i] = RH[o]; }
    __syncthreads();
    {
        LAS float* Ps = (LAS float*)(lds + 65536); LAS float* Hs = Ps + 512;
        const int c = tid & 63, seg = tid >> 6;
        float P = 1.f, H = 0.f;
#pragma unroll 4
        for (int i = 0; i < 16; ++i) { const int o = (seg * 16 + i) * 64 + c; const float cp = Pl[o]; H = cp * H + Hl[o]; P *= cp; }
        Ps[seg * 64 + c] = P; Hs[seg * 64 + c] = H;
        __syncthreads();
        float carry = 0.f;
        for (int s = 0; s < seg; ++s) carry = Ps[s * 64 + c] * carry + Hs[s * 64 + c];
#pragma unroll 4
        for (int i = 0; i < 16; ++i) { const int o = (seg * 16 + i) * 64 + c; const float cp = Pl[o], chh = Hl[o]; Pl[o] = carry; carry = cp * carry + chh; }
    }
    __syncthreads();
    for (int i = tid; i < 128 * 64; i += 512) { const int tl = i >> 6, c = i & 63; RC[(size_t)(b * 128 + tl) * DR + cg0 + c] = Pl[i]; }
    __syncthreads();
}

__global__ void __launch_bounds__(512, 2) hybrid_fwd(Params p_in) {
    extern __shared__ __attribute__((aligned(16))) unsigned char lds_raw[];
    LAS unsigned char* lds = (LAS unsigned char*)lds_raw;
    cg::grid_group grid = cg::this_grid();
    Params p = p_in; p.wv = __builtin_amdgcn_readfirstlane((int)threadIdx.x >> 6);
    unsigned char* ws = p.ws;
    const int G = gridDim.x, bid = blockIdx.x;
    const float* mod = (const float*)(ws + WS_MOD);
    bf16* U = (bf16*)(ws + WS_U); bf16* Hb = (bf16*)(ws + WS_H);
    bf16* XB = (bf16*)(ws + WS_XBH);
    volatile LAS unsigned* xst = (volatile LAS unsigned*)(lds + LDS_BYTES - 64);
    { const int t0_ = otid(p.wv); if (t0_ < 16) xst[t0_] = 0u; }
    __syncthreads();
    (void)xcd_barrier_post((unsigned*)(ws + WS_BAR), xst, p.wv);
#define GRID_BAR() do { XcdBarrier xb_; xb_.bar = (unsigned*)(ws + WS_BAR); xb_.x = xb_xcc_id(); xb_.st = (volatile LAS unsigned*)(lds + LDS_BYTES - 64); xb_.wv = p.wv; xcd_barrier(xb_); } while (0)
#ifdef PROBE_MASK
#define PR_SLOT ((volatile LAS unsigned long long*)(lds + LDS_BYTES - 128))
    if (bid == 0 && otid(p.wv) == 0) { PR_SLOT[0] = __builtin_amdgcn_s_memrealtime(); PR_SLOT[1] = 0ull; }
#define PH_END(k) do { if (bid == 0 && otid(p.wv) == 0) { const unsigned long long now_ = __builtin_amdgcn_s_memrealtime(); if ((PROBE_MASK >> (k)) & 1) PR_SLOT[1] += now_ - PR_SLOT[0]; PR_SLOT[0] = now_; } } while (0)
#else
#define PH_END(k) do { } while (0)
#endif

    if (p.ws == nullptr) grid.sync();
    p0_prologue(p, lds);
    GRID_BAR(); PH_END(0);
    row_pass(p, kin(I_X), false, nullptr, -1, 0, false, UP8_0, true, true, lds);
    GRID_BAR(); PH_END(1);
    { pg8::Gemm gm{U, (const bf16*)(ws + WS_W13A), M, 2 * FF, UP8_0 ? D / 2 : D, p.wv}; pg8::StaticOrder S; S.init(M, 2 * FF, G, bid);
      pg8::EpiSwiglu<DN8_0> E{Hb, FF, UP8_0 ? 1.0f / (FP8_ASCALE * FP8_WSCALE) : 1.0f, FP8_HSCALE}; pg8::gemm_phase<pg8::EpiSwiglu<DN8_0>, pg8::StaticOrder, true, true, UP8_0>(lds, gm, S, E); }
    GRID_BAR(); PH_END(2);
    { pg8::Gemm gm{Hb, (const bf16*)(ws + WS_W2A), M, D, DN8_0 ? FF / 2 : FF, p.wv}; pg8::StaticOrder S; S.init(M, D, G, bid);
      pg8::EpiRes<false> E{kin(I_X), XB, mod + 0 * 3 * D + 2 * D, nullptr, DN8_0 ? 0.5f / (FP8_HSCALE * FP8_W2SCALE) : 0.5f, 0}; pg8::gemm_phase<pg8::EpiRes<false>, pg8::StaticOrder, true, true, DN8_0>(lds, gm, S, E); }
    GRID_BAR(); PH_END(3);
    row_pass(p, XB, true, nullptr, 0, 1, true, false, false, false, lds);
    GRID_BAR(); PH_END(4);
    { pg8::Gemm gm{U, (const bf16*)(ws + WS_WIN), M, NPROJ, D, p.wv}; pg8::StaticOrder S; S.init(M, NPROJ, G, bid);
      pg8::EpiProj E{(bf16*)(ws + WS_PROJ), kin(I_BIN)}; pg8::gemm_phase<pg8::EpiProj, pg8::StaticOrder, true, true>(lds, gm, S, E); }
    GRID_BAR(); PH_END(5);
    for (int u = bid; u < 8 * NSC; u += G) m1_unit(p, u / NSC, u % NSC, lds);
    rg_phase(p, 0, lds);
    GRID_BAR(); PH_END(6);
    m2_scan(p);
    for (int u = bid; u < 32; u += G) rg_carry_unit(p, u, lds);
    GRID_BAR(); PH_END(7);
    for (int u = bid; u < 8 * NSC; u += G) m3_unit(p, u / NSC, u % NSC, lds);
    rg_phase(p, 1, lds);
    GRID_BAR(); PH_END(8);
    { pg8::Gemm gm{U, (const bf16*)(ws + WS_WOUT), M, D, D, p.wv}; pg8::StaticOrder S; S.init(M, D, G, bid);
      pg8::EpiRes<true> E{XB, XB, mod + 1 * 3 * D + 2 * D, (const float*)(ws + WS_STAT), 1.0f, 0};        pg8::gemm_phase<pg8::EpiRes<true>, pg8::StaticOrder, true, true>(lds, gm, S, E); }
    GRID_BAR(); PH_END(9);
    row_pass(p, XB, true, nullptr, 1, 2, false, UP8_1, false, false, lds);
    GRID_BAR(); PH_END(10);
    { pg8::Gemm gm{U, (const bf16*)(ws + WS_W13B), M, 2 * FF, UP8_1 ? D / 2 : D, p.wv}; pg8::StaticOrder S; S.init(M, 2 * FF, G, bid);
      pg8::EpiSwiglu<DN8_1> E{Hb, FF, UP8_1 ? 1.0f / (FP8_ASCALE * FP8_WSCALE) : 1.0f, FP8_HSCALE}; pg8::gemm_phase<pg8::EpiSwiglu<DN8_1>, pg8::StaticOrder, true, true, UP8_1>(lds, gm, S, E); }
    GRID_BAR(); PH_END(11);
    { pg8::Gemm gm{Hb, (const bf16*)(ws + WS_W2B), M, D, DN8_1 ? FF / 2 : FF, p.wv}; pg8::StaticOrder S; S.init(M, D, G, bid);
      pg8::EpiRes<true> E{XB, XB, mod + 2 * 3 * D + 2 * D, (const float*)(ws + WS_STAT), DN8_1 ? 0.5f / (FP8_HSCALE * FP8_W2SCALE) : 0.5f, 1};        pg8::gemm_phase<pg8::EpiRes<true>, pg8::StaticOrder, true, true, DN8_1>(lds, gm, S, E); }
    GRID_BAR(); PH_END(12);
    row_pass(p, XB, true, p.out, 2, -1, false, false, false, true, lds);
#ifdef PROBE_MASK
    grid.sync(); PH_END(13);
    if (bid == 0 && otid(p.wv) == 0) { *(volatile float*)(ws + WS_MDEC + 65536) = sqrtf((float)PR_SLOT[1] * 0.01f * 1e-5f); __threadfence(); }
    grid.sync();
    { const float E = *(volatile float*)(ws + WS_MDEC + 65536);
      for (int i = bid * 512 + otid(p.wv); i < M * D / 1024; i += G * 512) XB[(size_t)i * 1024] += E; }
#endif
}

extern "C" void kernel_launch(void* const* d_in, const int* in_sizes, int n_in, void* d_out, int out_size, void* d_ws, size_t ws_size, hipStream_t stream) {
    static int grid = 0;
    if (grid == 0) {
        if (n_in != 21 || out_size != M * D || ws_size < WS_END) { fprintf(stderr, "kernel_launch: unexpected shapes (n_in %d, out %d, ws %zu < %zu)\n", n_in, out_size, ws_size, (size_t)WS_END); grid = -1; return; }
        int dev = 0, cus = 0, per_cu = 0;
        hipGetDevice(&dev); hipDeviceGetAttribute(&cus, hipDeviceAttributeMultiprocessorCount, dev);
        if (hipFuncSetAttribute((const void*)hybrid_fwd, hipFuncAttributeMaxDynamicSharedMemorySize, LDS_BYTES) != hipSuccess) { fprintf(stderr, "kernel_launch: hipFuncSetAttribute failed\n"); grid = -1; return; }
        if (hipOccupancyMaxActiveBlocksPerMultiprocessor(&per_cu, (const void*)hybrid_fwd, 512, LDS_BYTES) != hipSuccess || per_cu < 1) { fprintf(stderr, "kernel_launch: occupancy query gives %d\n", per_cu); per_cu = 1; }
        (void)hipGetLastError();
        grid = cus;
    }
    if (grid < 0) return;
    hipMemsetAsync((char*)d_ws + WS_BAR, 0, XCD_BAR_WORDS * sizeof(unsigned), stream);
    Params p{};
    for (int i = 0; i < 21; ++i) p.in[i] = (const float*)d_in[i];
    p.out = (float*)d_out; p.ws = (unsigned char*)d_ws;
    void* args[] = {&p};
    hipError_t e = hipLaunchCooperativeKernel((const void*)hybrid_fwd, dim3(grid), dim3(512), args, LDS_BYTES, stream);
    if (e != hipSuccess) fprintf(stderr, "cooperative launch failed: %s (grid %d)\n", hipGetErrorString(e), grid);
}
```
